# Optimizing an MI355X kernel written in HIP

```python
import math
import jax, jax.numpy as jnp
from jax import lax
import numpy as np

D_MODEL = 1024
BATCH = 4
SEQ = 8192
DEPTH = 4

SSM_WIDTH = D_MODEL // 2
SSM_GROUP = 16
SSM_GROUPS = SSM_WIDTH // SSM_GROUP
SSM_STATE = 64
MLA_HEADS = 8
QK_NOPE = 64
QK_ROPE = 32
QK_HEAD = QK_NOPE + QK_ROPE
V_HEAD = 64
Q_LORA = 384
KV_LORA = 256
MLA_WIDTH = MLA_HEADS * V_HEAD
ROPE_THETA = 10000.0
Q_BLOCK = 128
D_FF = 4 * D_MODEL
EPS = 1e-6
IN_SIZES = (SSM_WIDTH, Q_LORA, KV_LORA, QK_ROPE, 2 * D_MODEL)
IN_COLS = sum(IN_SIZES)
IN_SPLITS = [int(v) for v in np.cumsum(IN_SIZES)[:-1]]

kernel_name = "hybrid_s5_mla_encoder"


def rms_norm(x, g):
    xf = x.astype(jnp.float32)
    y = xf * lax.rsqrt(jnp.mean(xf * xf, axis=-1, keepdims=True) + EPS)
    return (y * g.astype(jnp.float32)).astype(x.dtype)


def rope_tables(seq, dtype):
    half = QK_ROPE // 2
    inv_freq = ROPE_THETA ** (-jnp.arange(half, dtype=jnp.float32) / half)
    ang = jnp.arange(seq, dtype=jnp.float32)[:, None] * inv_freq[None, :]
    return jnp.cos(ang).astype(dtype), jnp.sin(ang).astype(dtype)


def apply_rope(x, cos, sin):
    x1, x2 = jnp.split(x, 2, axis=-1)
    return jnp.concatenate([x1 * cos - x2 * sin, x1 * sin + x2 * cos], axis=-1)


def _affine_combine(e1, e2):
    a1r, a1i, b1r, b1i = e1
    a2r, a2i, b2r, b2i = e2
    ar = a2r * a1r - a2i * a1i
    ai = a2r * a1i + a2i * a1r
    br = a2r * b1r - a2i * b1i + b2r
    bi = a2r * b1i + a2i * b1r + b2i
    return ar, ai, br, bi


def zoh_discretise(lam_re, lam_im, log_step, b_re, b_im):
    f32 = jnp.float32
    lam_re = lam_re.astype(f32); lam_im = lam_im.astype(f32)
    step = jnp.exp(log_step.astype(f32))[:, None]
    mag = jnp.exp(lam_re * step)
    abar_r = mag * jnp.cos(lam_im * step)
    abar_i = mag * jnp.sin(lam_im * step)
    nr = abar_r - 1.0
    ni = abar_i
    den = lam_re * lam_re + lam_im * lam_im
    fr = (nr * lam_re + ni * lam_im) / den
    fi = (ni * lam_re - nr * lam_im) / den
    b_re = b_re.astype(f32); b_im = b_im.astype(f32)
    bbar_r = fr[..., None] * b_re - fi[..., None] * b_im
    bbar_i = fr[..., None] * b_im + fi[..., None] * b_re
    return abar_r, abar_i, bbar_r, bbar_i


def s5_states(u, lam_re, lam_im, log_step, b_re, b_im, reverse):
    abar_r, abar_i, bbar_r, bbar_i = zoh_discretise(lam_re, lam_im, log_step, b_re, b_im)
    bu_r = jnp.einsum('bsgp,gnp->bsgn', u, bbar_r)
    bu_i = jnp.einsum('bsgp,gnp->bsgn', u, bbar_i)
    a_r = jnp.broadcast_to(abar_r, bu_r.shape)
    a_i = jnp.broadcast_to(abar_i, bu_i.shape)
    _, _, xr, xi = lax.associative_scan(_affine_combine, (a_r, a_i, bu_r, bu_i), reverse=reverse, axis=1)
    return xr, xi


def s5_branch(u, lam_re, lam_im, log_step, b_re, b_im, c_re, c_im, d, w_glu, b_glu):
    bsz, seq, _ = u.shape
    uf = u.astype(jnp.float32).reshape(bsz, seq, SSM_GROUPS, SSM_GROUP)
    xr_f, xi_f = s5_states(uf, lam_re[0], lam_im[0], log_step[0], b_re[0], b_im[0], reverse=False)
    xr_b, xi_b = s5_states(uf, lam_re[1], lam_im[1], log_step[1], b_re[1], b_im[1], reverse=True)
    xr = xr_f + xr_b
    xi = xi_f + xi_b
    y = (jnp.einsum('bsgn,gpn->bsgp', xr, c_re.astype(jnp.float32))
         - jnp.einsum('bsgn,gpn->bsgp', xi, c_im.astype(jnp.float32))
         + d.astype(jnp.float32) * uf)
    y = y.reshape(bsz, seq, SSM_WIDTH).astype(u.dtype)
    y = jax.nn.gelu(y)
    return y * jax.nn.sigmoid(y @ w_glu + b_glu)


def mla_branch(cq, ckv, k_rope, q_norm_g, kv_norm_g, w_q_up, w_kv_up, q_head_g, k_head_g, cos, sin):
    bsz, seq, _ = cq.shape
    q = (rms_norm(cq, q_norm_g) @ w_q_up).reshape(bsz, seq, MLA_HEADS, QK_HEAD)
    kv = (rms_norm(ckv, kv_norm_g) @ w_kv_up).reshape(bsz, seq, MLA_HEADS, QK_NOPE + V_HEAD)
    k_nope, v = kv[..., :QK_NOPE], kv[..., QK_NOPE:]
    k = jnp.concatenate([k_nope, jnp.broadcast_to(k_rope[:, :, None, :], (bsz, seq, MLA_HEADS, QK_ROPE))], axis=-1)
    q = rms_norm(q, q_head_g)
    k = rms_norm(k, k_head_g)
    c4, s4 = cos[None, :, None, :], sin[None, :, None, :]
    q = jnp.concatenate([q[..., :QK_NOPE], apply_rope(q[..., QK_NOPE:], c4, s4)], axis=-1)
    k = jnp.concatenate([k[..., :QK_NOPE], apply_rope(k[..., QK_NOPE:], c4, s4)], axis=-1)
    q = q * (QK_HEAD ** -0.5)
    n_blk = seq // Q_BLOCK
    qb = q.reshape(bsz, n_blk, Q_BLOCK, MLA_HEADS, QK_HEAD).transpose(1, 0, 2, 3, 4)

    def attend(q_blk):
        s = jnp.einsum('bqhd,bkhd->bhqk', q_blk, k, preferred_element_type=jnp.float32)
        p = jax.nn.softmax(s, axis=-1)
        return jnp.einsum('bhqk,bkhd->bqhd', p.astype(v.dtype), v)

    o = lax.map(attend, qb)
    return o.transpose(1, 0, 2, 3, 4).reshape(bsz, seq, MLA_WIDTH)


def setup_inputs(seed: int = 0) -> dict:
    key = jax.random.key(seed)
    ks = jax.random.split(key, 32)
    f32 = jnp.float32
    G, N, P = SSM_GROUPS, SSM_STATE, SSM_GROUP

    def nrm(k, shape, scale):
        return jax.random.normal(k, shape, f32) * scale

    def gain(k, shape):
        return 1.0 + 0.05 * jax.random.normal(k, shape, f32)

    n_idx = jnp.arange(N, dtype=f32)
    lam_re = -0.5 + 0.01 * jax.random.normal(ks[4], (DEPTH, 2, G, N), f32)
    lam_im = math.pi * n_idx + 0.01 * jax.random.normal(ks[5], (DEPTH, 2, G, N), f32)
    log_step = jax.random.uniform(ks[6], (DEPTH, 2, G), f32, math.log(1e-3), math.log(1e-1))
    b_scale = (1.0 / math.sqrt(P)) / math.sqrt(2.0)
    c_scale = (1.0 / math.sqrt(N)) / math.sqrt(2.0)
    return {
        "x": jax.random.normal(ks[0], (BATCH, SEQ, D_MODEL), f32),
        "mix_norm_g": gain(ks[1], (DEPTH, D_MODEL)),
        "w_in": nrm(ks[2], (DEPTH, D_MODEL, IN_COLS), D_MODEL ** -0.5),
        "b_gate": nrm(ks[3], (DEPTH, 2, D_MODEL), 0.02),
        "ssm_lam_re": lam_re,
        "ssm_lam_im": lam_im,
        "ssm_log_step": log_step,
        "ssm_b_re": nrm(ks[7], (DEPTH, 2, G, N, P), b_scale),
        "ssm_b_im": nrm(ks[8], (DEPTH, 2, G, N, P), b_scale),
        "ssm_c_re": nrm(ks[9], (DEPTH, G, P, N), c_scale),
        "ssm_c_im": nrm(ks[10], (DEPTH, G, P, N), c_scale),
        "ssm_d": nrm(ks[11], (DEPTH, G, P), 1.0),
        "w_glu": nrm(ks[12], (DEPTH, SSM_WIDTH, SSM_WIDTH), SSM_WIDTH ** -0.5),
        "b_glu": nrm(ks[13], (DEPTH, SSM_WIDTH), 0.02),
        "w_out_ssm": nrm(ks[14], (DEPTH, SSM_WIDTH, D_MODEL), SSM_WIDTH ** -0.5),
        "q_norm_g": gain(ks[15], (DEPTH, Q_LORA)),
        "kv_norm_g": gain(ks[16], (DEPTH, KV_LORA)),
        "w_q_up": nrm(ks[17], (DEPTH, Q_LORA, MLA_HEADS * QK_HEAD), Q_LORA ** -0.5),
        "w_kv_up": nrm(ks[18], (DEPTH, KV_LORA, MLA_HEADS * (QK_NOPE + V_HEAD)), KV_LORA ** -0.5),
        "q_head_g": gain(ks[19], (DEPTH, QK_HEAD)),
        "k_head_g": gain(ks[20], (DEPTH, QK_HEAD)),
        "w_out_mla": nrm(ks[21], (DEPTH, MLA_WIDTH, D_MODEL), MLA_WIDTH ** -0.5),
        "w_o": nrm(ks[22], (DEPTH, D_MODEL, D_MODEL), D_MODEL ** -0.5),
        "ffn_norm_g": gain(ks[23], (DEPTH, D_MODEL)),
        "w_ff1": nrm(ks[24], (DEPTH, D_MODEL, D_FF), D_MODEL ** -0.5),
        "w_ff2": nrm(ks[25], (DEPTH, D_FF, D_MODEL), D_FF ** -0.5),
    }


def reference(x, mix_norm_g, w_in, b_gate, ssm_lam_re, ssm_lam_im, ssm_log_step, ssm_b_re, ssm_b_im,
              ssm_c_re, ssm_c_im, ssm_d, w_glu, b_glu, w_out_ssm, q_norm_g, kv_norm_g, w_q_up, w_kv_up,
              q_head_g, k_head_g, w_out_mla, w_o, ffn_norm_g, w_ff1, w_ff2):
    bsz, seq, _ = x.shape
    cos, sin = rope_tables(seq, x.dtype)
    for l in range(DEPTH):
        h = rms_norm(x, mix_norm_g[l])
        proj = h @ w_in[l]
        u_ssm, cq, ckv, k_rope, gate_pre = jnp.split(proj, IN_SPLITS, axis=-1)
        gates = jax.nn.sigmoid(gate_pre.reshape(bsz, seq, 2, D_MODEL) + b_gate[l])
        y_ssm = s5_branch(u_ssm, ssm_lam_re[l], ssm_lam_im[l], ssm_log_step[l], ssm_b_re[l], ssm_b_im[l],
                          ssm_c_re[l], ssm_c_im[l], ssm_d[l], w_glu[l], b_glu[l])
        y_mla = mla_branch(cq, ckv, k_rope, q_norm_g[l], kv_norm_g[l], w_q_up[l], w_kv_up[l],
                           q_head_g[l], k_head_g[l], cos, sin)
        merged = gates[:, :, 0, :] * (y_ssm @ w_out_ssm[l]) + gates[:, :, 1, :] * (y_mla @ w_out_mla[l])
        x = x + merged @ w_o[l]
        h = rms_norm(x, ffn_norm_g[l])
        x = x + jnp.square(jax.nn.relu(h @ w_ff1[l])) @ w_ff2[l]
    return x
```

```cpp
#include <hip/hip_runtime.h>
#include <hip/hip_cooperative_groups.h>
#include <cstdio>
#include <cstdint>
namespace cg = cooperative_groups;
namespace pg8 {
#define PG8_LAS __attribute__((address_space(3)))
typedef unsigned short bf16_t;
typedef short bf16x8 __attribute__((ext_vector_type(8)));
typedef float f32x4 __attribute__((ext_vector_type(4)));
typedef unsigned u32x4 __attribute__((ext_vector_type(4)));
constexpr int BM = 256, BK = 64, HALF = 128, HTB = HALF * BK * 2  , STAGE_BYTES = 8 * HTB, NXCD = 8, WGM = 8;

__host__ __device__ __forceinline__ int lds_byte(int r, int c) { const int st = (r >> 4) * 2 + (c >> 5), rr = r & 15, cc = c & 31, ob = rr * 64 + cc * 2; return st * 1024 + (ob ^ (((ob >> 9) & 1) << 5)); }
__host__ __device__ __forceinline__ void stage_rc(int b, int& R, int& C) { const int st = b / 1024, sb = b % 1024, swz = sb ^ (((sb >> 9) & 1) << 5); R = (st >> 1) * 16 + swz / 64; C = (st & 1) * 32 + (swz % 64) / 2; }
__host__ __device__ __forceinline__ int perm32(int rho) { const int n = rho >> 4, i = rho & 15; return 8 * (i >> 2) + 4 * n + (i & 3); }

struct Unit { int pm, pn, ph; };
struct Gemm { const bf16_t* A; const bf16_t* Bt; int M, N, K; int a_gm; const bf16_t* A2; const bf16_t* Bt2; };

struct StaticOrder {
    int nM, nN, nwg, G, c;
    __host__ __device__ void init(int M, int N, int G_, int c_) { nM = M / BM; nN = N / BM; nwg = nM * nN; G = G_; c = c_; }
    __host__ __device__ bool next(int i, Unit& u) const {
        const long L = (long)i * G + c; if (L >= nwg) return false;
        int wgid = (int)L; { const int q = nwg / NXCD, r = nwg % NXCD, xcd = wgid % NXCD, off = wgid / NXCD; wgid = (xcd < r ? xcd * (q + 1) : r * (q + 1) + (xcd - r) * q) + off; }
        const int nig = WGM * nN, gid = wgid / nig, fm = gid * WGM, gsz = (nM - fm) < WGM ? (nM - fm) : WGM;
        u.pm = fm + ((wgid % nig) % gsz); u.pn = (wgid % nig) / gsz; return true;
    }
    __device__ __forceinline__ void a_ready(const Unit&) const {}
    __device__ __forceinline__ void done(const Unit&) const {}
};

__device__ __forceinline__ unsigned cvt_pk_bf16(float lo, float hi) { unsigned r; asm volatile("v_cvt_pk_bf16_f32 %0, %1, %2" : "=v"(r) : "v"(lo), "v"(hi)); return r; }
typedef float f32x2 __attribute__((ext_vector_type(2)));
template <class Epi, class Sched, bool ALIGN_EPI = false, bool SP2 = false>
__device__ __forceinline__ void gemm_phase(PG8_LAS unsigned char* lds, const Gemm g, const Sched& S, const Epi& E, const int tid_in) {
    const int tid = tid_in, wid = __builtin_amdgcn_readfirstlane(tid >> 6), lane = tid & 63, wr = wid >> 2, wc = wid & 3, fr = lane & 15, fq = lane >> 4;
    const int K = g.K, nt = K / BK;
    unsigned voffA[2], voffB[2];
#pragma unroll
    for (int i = 0; i < 2; ++i) { int R, C; stage_rc(tid * 16 + i * 8192, R, C); const int Rb = Epi::PERM ? ((R & ~31) + perm32(R & 31)) : R;
        voffA[i] = g.a_gm ? (unsigned)((C >> 4) * g.a_gm * 32 + R * 32 + (C & 15) * 2) : (unsigned)(R * K + C) * 2u; voffB[i] = (unsigned)(Rb * K + C) * 2u; }
    const size_t kstep = (size_t)(BK * 2);
    const size_t hstep = (size_t)HALF * K * 2;
    const size_t tstep = 2 * hstep;
    const size_t kstepA = g.a_gm ? (size_t)4 * g.a_gm * 32 : kstep, hstepA = g.a_gm ? (size_t)HALF * 32 : hstep, tstepA = 2 * hstepA;
    const unsigned ldsw = (unsigned)wid * 1024u;
    const int aoff = lds_byte(wr * 64 + fr, fq * 8), boff = lds_byte(wc * 32 + fr, fq * 8);
#define PG8_SA(b, h) (((b) * 2 + (h)) * HTB)
#define PG8_SB(b, h) ((4 + (b) * 2 + (h)) * HTB)
#define PG8_STAGE(bufoff, gbase, voff) do { _Pragma("unroll") for (int _i = 0; _i < 2; ++_i) \
        __builtin_amdgcn_global_load_lds((const unsigned*)((const char*)(gbase) + (voff)[_i]), (PG8_LAS unsigned*)(lds + (bufoff) + ldsw + _i * 8192), 16, 0, 0); } while (0)
#define PG8_LDA(dst, b, h) do { _Pragma("unroll") for (int m = 0; m < 4; ++m) _Pragma("unroll") for (int k = 0; k < 2; ++k) dst[m][k] = *(const PG8_LAS bf16x8*)(lds + PG8_SA(b, h) + aoff + m * 2048 + k * 1024); } while (0)
#define PG8_LDB(dst, b, h) do { _Pragma("unroll") for (int n = 0; n < 2; ++n) _Pragma("unroll") for (int k = 0; k < 2; ++k) dst[n][k] = *(const PG8_LAS bf16x8*)(lds + PG8_SB(b, h) + boff + n * 2048 + k * 1024); } while (0)
#define PG8_MMA(ai, bj, At, Bt) do { __builtin_amdgcn_s_setprio(1); _Pragma("unroll") for (int m = 0; m < 4; ++m) _Pragma("unroll") for (int n = 0; n < 2; ++n) _Pragma("unroll") for (int k = 0; k < 2; ++k) \
        acc[ai][bj][m][n] = __builtin_amdgcn_mfma_f32_16x16x32_bf16(Bt[n][k], At[m][k], acc[ai][bj][m][n], 0, 0, 0); __builtin_amdgcn_s_setprio(0); } while (0)
#define PG8_WAIT_V(n) asm volatile("s_waitcnt vmcnt(" #n ")" ::: "memory")
#define PG8_WAIT_L(n) asm volatile("s_waitcnt lgkmcnt(" #n ")" ::: "memory")
#define PG8_BAR __builtin_amdgcn_s_barrier()
#define PG8_SCHED __builtin_amdgcn_sched_barrier(0)
    Unit cur, nxt; int ui = 0;
    if (!S.next(0, cur)) return;
    f32x4 acc[2][2][4][2];
#pragma unroll
    for (int a = 0; a < 2; ++a)
#pragma unroll
        for (int b = 0; b < 2; ++b)
#pragma unroll
            for (int m = 0; m < 4; ++m)
#pragma unroll
                for (int n = 0; n < 2; ++n) acc[a][b][m][n] = (f32x4){0.f, 0.f, 0.f, 0.f};
    bf16x8 At[4][2], B0[2][2], B1[2][2];
    const char* cA = (const char*)((g.A2 && cur.ph) ? g.A2 : g.A) + (size_t)cur.pm * tstepA; const char* cB = (const char*)((g.A2 && cur.ph) ? g.Bt2 : g.Bt) + (size_t)cur.pn * tstep;
    S.a_ready(cur, 0);
    if constexpr (SP2) {
        PG8_STAGE(PG8_SB(0, 0), cB, voffB); PG8_STAGE(PG8_SB(0, 1), cB + hstep, voffB); PG8_STAGE(PG8_SA(0, 0), cA, voffA); PG8_STAGE(PG8_SA(0, 1), cA + hstepA, voffA);
        if (wr == 1) PG8_BAR;
        PG8_WAIT_V(2); PG8_BAR;
        PG8_STAGE(PG8_SB(1, 0), cB + kstep, voffB); PG8_STAGE(PG8_SA(1, 0), cA + kstepA, voffA); PG8_STAGE(PG8_SB(1, 1), cB + hstep + kstep, voffB);
        PG8_WAIT_V(6); PG8_BAR;
    } else {
        PG8_STAGE(PG8_SB(0, 0), cB, voffB); PG8_STAGE(PG8_SA(0, 0), cA, voffA); PG8_STAGE(PG8_SB(0, 1), cB + hstep, voffB); PG8_STAGE(PG8_SA(0, 1), cA + hstepA, voffA);
        if (wr == 1) PG8_BAR;
        PG8_WAIT_V(4); PG8_BAR;
        PG8_STAGE(PG8_SB(1, 0), cB + kstep, voffB); PG8_STAGE(PG8_SA(1, 0), cA + kstepA, voffA); PG8_STAGE(PG8_SB(1, 1), cB + hstep + kstep, voffB);
        PG8_WAIT_V(6); PG8_BAR;
    }
    for (;;) {
        const bool has_next = S.next(ui + 1, nxt);
        const char* nA = has_next ? (const char*)((g.A2 && nxt.ph) ? g.A2 : g.A) + (size_t)nxt.pm * tstepA : cA; const char* nB = has_next ? (const char*)((g.A2 && nxt.ph) ? g.Bt2 : g.Bt) + (size_t)nxt.pn * tstep : cB;
        for (int t = 0; t < nt; t += 2) {
            const bool last = (t == nt - 2);
            const char* a1 = cA + (size_t)(t + 1) * kstepA;
            const char* a2 = last ? nA : cA + (size_t)(t + 2) * kstepA; const char* b2 = last ? nB : cB + (size_t)(t + 2) * kstep;
            const char* a3 = a2 + kstepA; const char* b3 = b2 + kstep;
            if (last && has_next) S.a_ready(nxt, ui + 1);
            if constexpr (SP2) {
            PG8_LDB(B0, 0, 0); PG8_LDB(B1, 0, 1); PG8_SCHED; PG8_LDA(At, 0, 0); PG8_STAGE(PG8_SA(1, 1), a1 + hstepA, voffA);
            PG8_WAIT_V(8); PG8_WAIT_L(0); PG8_BAR; PG8_MMA(0, 0, At, B0); PG8_MMA(0, 1, At, B1); PG8_BAR; PG8_SCHED;
            PG8_LDA(At, 0, 1); PG8_STAGE(PG8_SB(0, 0), b2, voffB); PG8_STAGE(PG8_SB(0, 1), b2 + hstep, voffB); PG8_STAGE(PG8_SA(0, 0), a2, voffA);
            PG8_WAIT_V(8); PG8_WAIT_L(0); PG8_BAR; PG8_MMA(1, 0, At, B0); PG8_MMA(1, 1, At, B1); PG8_BAR; PG8_SCHED;
            PG8_LDB(B0, 1, 0); PG8_LDB(B1, 1, 1); PG8_SCHED; PG8_LDA(At, 1, 0); PG8_STAGE(PG8_SA(0, 1), a2 + hstepA, voffA);
            PG8_WAIT_V(8); PG8_WAIT_L(0); PG8_BAR; PG8_MMA(0, 0, At, B0); PG8_MMA(0, 1, At, B1); PG8_BAR; PG8_SCHED;
            PG8_LDA(At, 1, 1); PG8_STAGE(PG8_SB(1, 0), b3, voffB); PG8_STAGE(PG8_SB(1, 1), b3 + hstep, voffB); PG8_STAGE(PG8_SA(1, 0), a3, voffA);
            PG8_WAIT_V(8); PG8_WAIT_L(0); PG8_BAR; PG8_MMA(1, 0, At, B0); PG8_MMA(1, 1, At, B1); PG8_BAR; PG8_SCHED;
            } else {
            PG8_LDB(B0, 0, 0); PG8_SCHED; PG8_LDA(At, 0, 0); PG8_STAGE(PG8_SA(1, 1), a1 + hstepA, voffA);
            PG8_WAIT_L(8); PG8_BAR; PG8_WAIT_L(0); PG8_MMA(0, 0, At, B0); PG8_BAR; PG8_SCHED;
            PG8_LDB(B1, 0, 1); PG8_STAGE(PG8_SB(0, 0), b2, voffB);
            PG8_BAR; PG8_WAIT_L(0); PG8_MMA(0, 1, At, B1); PG8_BAR;
            PG8_LDA(At, 0, 1); PG8_STAGE(PG8_SA(0, 0), a2, voffA);
            PG8_BAR; PG8_WAIT_L(0); PG8_MMA(1, 0, At, B0); PG8_BAR; PG8_SCHED;
            PG8_STAGE(PG8_SB(0, 1), b2 + hstep, voffB);
            PG8_WAIT_V(6); PG8_BAR; PG8_MMA(1, 1, At, B1); PG8_BAR;
            PG8_LDB(B0, 1, 0); PG8_SCHED; PG8_LDA(At, 1, 0); PG8_STAGE(PG8_SA(0, 1), a2 + hstepA, voffA);
            PG8_WAIT_L(8); PG8_BAR; PG8_WAIT_L(0); PG8_MMA(0, 0, At, B0); PG8_BAR; PG8_SCHED;
            PG8_LDB(B1, 1, 1); PG8_STAGE(PG8_SB(1, 0), b3, voffB);
            PG8_BAR; PG8_WAIT_L(0); PG8_MMA(0, 1, At, B1); PG8_BAR;
            PG8_LDA(At, 1, 1); PG8_STAGE(PG8_SA(1, 0), a3, voffA);
            PG8_BAR; PG8_WAIT_L(0); PG8_MMA(1, 0, At, B0); PG8_BAR; PG8_SCHED;
            PG8_STAGE(PG8_SB(1, 1), b3 + hstep, voffB);
            PG8_WAIT_V(6); PG8_BAR; PG8_MMA(1, 1, At, B1); PG8_BAR;
            }
        }
        if constexpr (ALIGN_EPI) { if (wr == 0) PG8_BAR; }
        const bool chain_mid = g.A2 && cur.ph == 0;
        if constexpr (!Epi::AFTER_DRAIN) { if (chain_mid) E.mid(acc, cur, wr, wc); else E(acc, cur, wr, wc, fr, fq, ui); S.done(cur); }
        if (!has_next) break;
        if (!chain_mid) {
#pragma unroll
        for (int a = 0; a < 2; ++a)
#pragma unroll
            for (int b = 0; b < 2; ++b)
#pragma unroll
                for (int m = 0; m < 4; ++m)
#pragma unroll
                    for (int n = 0; n < 2; ++n) acc[a][b][m][n] = (f32x4){0.f, 0.f, 0.f, 0.f};
        }
        cur = nxt; cA = nA; cB = nB; ++ui;
        if constexpr (ALIGN_EPI) { if (wr == 1) PG8_BAR; }
    }
    PG8_WAIT_V(0);
    if constexpr (!ALIGN_EPI) { if (wr == 0) PG8_BAR; }
    PG8_BAR;
    if constexpr (Epi::AFTER_DRAIN) { E.fused(acc, cur, wr, wc, fr, fq, lds, wid, lane); S.done(cur); }
#undef PG8_SA
#undef PG8_SB
#undef PG8_STAGE
#undef PG8_LDA
#undef PG8_LDB
#undef PG8_MMA
#undef PG8_WAIT_V
#undef PG8_WAIT_L
#undef PG8_BAR
#undef PG8_SCHED
}
}
#ifndef PROBE_SC_MODE
#define PROBE_SC_MODE 0
#endif
#ifndef PROBE_SC_STAGE
#define PROBE_SC_STAGE 1
#endif
#ifndef PROBE_SC_MMA
#define PROBE_SC_MMA 0
#endif
#ifndef ATT_USE_SCHED
#define ATT_USE_SCHED 0
#endif

typedef unsigned short bf16;
typedef short bf16x8 __attribute__((ext_vector_type(8)));
typedef float f32x4 __attribute__((ext_vector_type(4)));
typedef float f32x2 __attribute__((ext_vector_type(2)));
typedef float f32x16 __attribute__((ext_vector_type(16)));
typedef unsigned u32x4 __attribute__((ext_vector_type(4)));
typedef unsigned u32x2 __attribute__((ext_vector_type(2)));
#define LAS __attribute__((address_space(3)))

constexpr int NTOK = 32768, SEQ = 8192, NBATCH = 4, DM = 1024, DEPTH = 4, DFF = 4096;
constexpr int NG = 32, NP = 16, NS = 64;
constexpr int LCH = 64, NCH = SEQ / LCH, NCOL = NBATCH * NCH;
constexpr int NH = 8, QKD = 96, VD = 64;
constexpr float EPS = 1e-6f;
constexpr int NTHREADS = 512, NWAVES = 8;

constexpr size_t MiB = (size_t)1 << 20;
constexpr size_t WS_PXM = 0;
constexpr size_t WS_ROPE = 2 * MiB;
constexpr size_t WS_PTAB = 3 * MiB;
constexpr size_t WS_BAR = 11 * MiB + 512 * 1024;
constexpr size_t WS_BBAR = 12 * MiB;
constexpr size_t WS_W = 14 * MiB, W_STRIDE = 29425664;
constexpr size_t WO_INS = 0;
constexpr size_t WO_G = WO_INS + (size_t)1280 * 1024 * 2;
constexpr size_t WO_Q = WO_G + (size_t)2048 * 1024 * 2;
constexpr size_t WO_KN = WO_Q + (size_t)768 * 384 * 2;
constexpr size_t WO_V = WO_KN + (size_t)512 * 256 * 2;
constexpr size_t WO_GLU = WO_V + (size_t)512 * 256 * 2;
constexpr size_t WO_OS = WO_GLU + (size_t)512 * 512 * 2;
constexpr size_t WO_OM = WO_OS + (size_t)1024 * 512 * 2;
constexpr size_t WO_O = WO_OM + (size_t)1024 * 512 * 2;
constexpr size_t WO_1 = WO_O + (size_t)1024 * 1024 * 2;
constexpr size_t WO_2 = WO_1 + (size_t)4096 * 1024 * 2;
static_assert(WO_2 + (size_t)4096 * 1024 * 2 <= W_STRIDE, "weights per layer");
constexpr size_t WS_PXF = WS_W + DEPTH * W_STRIDE;
constexpr size_t WS_PCQ = WS_PXF + 2 * MiB;
constexpr size_t WS_PCKV = WS_PCQ + 1 * MiB;
static_assert(WS_PCKV + MiB / 2 <= 130 * MiB, "partials");
constexpr size_t WS_XB = 130 * MiB;
constexpr size_t WS_KT = WS_XB + 64 * MiB;
constexpr size_t WS_WA = WS_KT + 2 * MiB;
constexpr size_t WS_WC = WS_WA + 16 * MiB;
constexpr size_t WS_SMALL = WS_WC + 16 * MiB;
constexpr int SM_CRE = 0, SM_CIM = 131072, SM_BG = 262144, SM_BGLU = 270336, SM_DD = 272384, SM_QG = 274432, SM_KG = 274816, SM_END = 275200;
constexpr size_t WS_AR = WS_WC + 16 * MiB + 2 * MiB;
constexpr size_t AR_U = WS_AR, AR_CQ = WS_AR + 32 * MiB, AR_CKV = WS_AR + 56 * MiB, AR_KR = WS_AR + 72 * MiB, AR_Q = WS_AR + 74 * MiB, AR_KN = WS_AR + 122 * MiB,
                 AR_VT = WS_AR + 154 * MiB, AR_K = WS_AR + 186 * MiB, AR_S = WS_AR + 234 * MiB, AR_H = WS_AR + 250 * MiB;
constexpr size_t AR_O = WS_AR + 32 * MiB, AR_YG = WS_AR + 122 * MiB, AR_GATES = WS_AR + 154 * MiB, AR_YSSM = WS_AR, AR_MRG = WS_AR + 64 * MiB, AR_HID = WS_AR;
constexpr size_t WS_END = WS_AR + 282 * MiB;
static_assert(WS_END == 512 * MiB, "ws map");

__device__ __forceinline__ unsigned f2bf(float f) { unsigned u = __builtin_bit_cast(unsigned, f); return (u + 0x7fffu + ((u >> 16) & 1u)) >> 16; }
__device__ __forceinline__ unsigned pk2(float lo, float hi) { return pg8::cvt_pk_bf16(lo, hi); }
__device__ __forceinline__ float bflo(unsigned w) { return __builtin_bit_cast(float, w << 16); }
__device__ __forceinline__ float bfhi(unsigned w) { return __builtin_bit_cast(float, w & 0xffff0000u); }
__device__ __forceinline__ u32x4 pack8(f32x4 a, f32x4 b) { u32x4 w; w.x = pk2(a[0], a[1]); w.y = pk2(a[2], a[3]); w.z = pk2(b[0], b[1]); w.w = pk2(b[2], b[3]); return w; }
__device__ __forceinline__ void unpack8(u32x4 w, f32x4& a, f32x4& b) { a = (f32x4){bflo(w.x), bfhi(w.x), bflo(w.y), bfhi(w.y)}; b = (f32x4){bflo(w.z), bfhi(w.z), bflo(w.w), bfhi(w.w)}; }
__device__ __forceinline__ int lane_id_asm() { int l; asm volatile("v_mbcnt_lo_u32_b32 %0, -1, 0\n\tv_mbcnt_hi_u32_b32 %0, -1, %0" : "=v"(l)); return l; }
__device__ __forceinline__ int opaque_tid(int wv) { asm volatile("" : "+s"(wv)); return wv * 64 + lane_id_asm(); }
__device__ __forceinline__ float sigmoidf_(float x) { return __builtin_amdgcn_rcpf(1.f + __expf(-x)); }
__device__ __forceinline__ float gelu_tanh(float x) { const float z = 0.7978845608028654f * (x + 0.044715f * x * x * x); const float t = 1.f - 2.f * __builtin_amdgcn_rcpf(__builtin_amdgcn_exp2f(2.8853900817779268f * z) + 1.f); return 0.5f * x * (1.f + t); }
__device__ __forceinline__ float wave_sum(float v) {
#pragma unroll
    for (int o = 1; o < 64; o <<= 1) v += __shfl_xor(v, o);
    return v;
}
__device__ __forceinline__ float sumsq8(f32x4 a, f32x4 b) { return (a[0] * a[0] + a[1] * a[1]) + (a[2] * a[2] + a[3] * a[3]) + (b[0] * b[0] + b[1] * b[1]) + (b[2] * b[2] + b[3] * b[3]); }
__device__ __forceinline__ void row_part_store(float s, float* dst) {
    s += __shfl_xor(s, 16); s += __shfl_xor(s, 32);
    if ((lane_id_asm() >> 4) == 0) *dst = s;
}
__device__ __forceinline__ float hsum4(f32x4 v) { return (v[0] + v[1]) + (v[2] + v[3]); }
__device__ __forceinline__ float sum16(const float* p) { const f32x4* q = (const f32x4*)p; return hsum4((q[0] + q[1]) + (q[2] + q[3])); }
__device__ __forceinline__ float sum8(const float* p) { const f32x4* q = (const f32x4*)p; return hsum4(q[0] + q[1]); }
__device__ __forceinline__ float sum4(const float* p) { return hsum4(*(const f32x4*)p); }

constexpr int LDS_TAB = 131072 + 64;
struct NoPre {};
struct PreRs { float rs; };
template <class T> struct IsChainF { static constexpr bool v = false; };
struct Pre4 { f32x4 v[4]; };
struct PreU2 { u32x4 a, b; };
struct PreU4 { u32x4 a, b, c, d; };
template <class F> struct HookSched {
    pg8::StaticOrder so; F f; LAS unsigned char* lds; int wv; bool chain;
    __device__ __forceinline__ bool next(int i, pg8::Unit& u) const { const bool ok = so.next(chain ? (i >> 1) : i, u); u.ph = chain ? (i & 1) : 0; return ok; }
    __device__ __forceinline__ void a_ready(const pg8::Unit& u, int ui) const {
        if (F::USE_TAB) { const int t = wv * 64 + lane_id_asm(); ((LAS float*)(lds + LDS_TAB))[(ui & 1) * 512 + t] = f.table_val(u.pm, u.pn, t); } }
    __device__ __forceinline__ void done(const pg8::Unit&) const {}
};
template <class F> struct EpiRow8 {
    static constexpr bool PERM = true, AFTER_DRAIN = false; F f; LAS unsigned char* lds;
    __device__ __forceinline__ void mid(pg8::f32x4 (&acc)[2][2][4][2], const pg8::Unit& u, int wr, int wc) const {
        if constexpr (IsChainF<F>::v) {
            const int ln_ = lane_id_asm(), fr = ln_ & 15, fq = ln_ >> 4;
            int col = u.pn * 256 + wc * 32 + 8 * fq; asm volatile("" : "+v"(col));
#pragma unroll
            for (int g = 0; g < 8; g += 2) {
                PreU4 rp[2];
#pragma unroll
                for (int j = 0; j < 2; ++j) { const int ai = (g + j) >> 2, mm = (g + j) & 3; int row = u.pm * 256 + ai * 128 + wr * 64 + mm * 16 + fr; asm volatile("" : "+v"(row)); rp[j] = f.mid_pre(row, col); }
#pragma unroll
                for (int j = 0; j < 2; ++j) { const int ai = (g + j) >> 2, mm = (g + j) & 3; f.mid_apply(rp[j], acc[ai][0][mm][0], acc[ai][0][mm][1], acc[ai][1][mm][0], acc[ai][1][mm][1]); }
                asm volatile("" ::: "memory");
            }
        }
    }
    __device__ __forceinline__ void operator()(const pg8::f32x4 (&acc)[2][2][4][2], const pg8::Unit& u, int wr, int wc, int, int, int ui) const {
        const int ln_ = lane_id_asm(), fr = ln_ & 15, fq = ln_ >> 4;
        int col = u.pn * 256 + wc * 32 + 8 * fq; asm volatile("" : "+v"(col));
        const LAS float* tab = (const LAS float*)(lds + LDS_TAB) + (ui & 1) * 512;
        Pre4 cv = f.pre_col(col);
        if (F::USE_TAB) { const LAS float* tc = tab + 256 + wc * 32 + 8 * fq; cv.v[0] = *(const LAS f32x4*)tc; cv.v[1] = *(const LAS f32x4*)(tc + 4); cv.v[2] = *(const LAS f32x4*)(tc + 128); cv.v[3] = *(const LAS f32x4*)(tc + 132); }
        constexpr int NB = F::BATCH;
#pragma unroll
        for (int g = 0; g < 8; g += NB) {
            typename F::RowPre rp[NB]; int rows[NB]; float rv[NB];
#pragma unroll
            for (int j = 0; j < NB; ++j) { const int ai = (g + j) >> 2, mm = (g + j) & 3; const int rl = ai * 128 + wr * 64 + mm * 16 + fr; int row = u.pm * 256 + rl; asm volatile("" : "+v"(row)); rows[j] = row;
                rv[j] = F::USE_TAB ? tab[rl] : 0.f; rp[j] = f.pre_row(row, col); }
#pragma unroll
            for (int j = 0; j < NB; ++j) { const int ai = (g + j) >> 2, mm = (g + j) & 3; f.apply(rows[j], col, rv[j], cv, rp[j], acc[ai][0][mm][0], acc[ai][0][mm][1], acc[ai][1][mm][0], acc[ai][1][mm][1]); }
            asm volatile("" ::: "memory");
        }
    }
};
struct FInSmall { typedef NoPre RowPre; static constexpr int BATCH = 2; static constexpr bool USE_TAB = true;
    const float* px; float* pcq; float* pckv; bf16 *u, *ckv, *cq, *kr;
    __device__ __forceinline__ float table_val(int pm, int, int t) const { return t < 256 ? rsqrtf(sum16(px + (size_t)(pm * 256 + t) * 16) * (1.f / 1024.f) + EPS) : 0.f; }
    __device__ __forceinline__ Pre4 pre_col(int) const { return Pre4{}; }
    __device__ __forceinline__ RowPre pre_row(int, int) const { return NoPre{}; }
    __device__ __forceinline__ void apply(int row, int col, float rs, const Pre4&, const RowPre&, f32x4 a0, f32x4 b0, f32x4 a1, f32x4 b1) const {
        a0 = a0 * rs; b0 = b0 * rs; a1 = a1 * rs; b1 = b1 * rs;
        const int pn = col >> 8, wc = (col >> 5) & 3;
        if (pn < 2) { *(u32x4*)(u + (size_t)row * 512 + col) = pack8(a0, b0); *(u32x4*)(u + (size_t)row * 512 + col + 128) = pack8(a1, b1); }
        else if (pn == 2) { bf16* d = ckv + (size_t)row * 256 + (col - 512); *(u32x4*)d = pack8(a0, b0); *(u32x4*)(d + 128) = pack8(a1, b1);
            row_part_store(sumsq8(a0, b0) + sumsq8(a1, b1), pckv + (size_t)row * 4 + wc); }
        else if (pn == 3) { bf16* d = cq + (size_t)row * 384 + (col - 768); *(u32x4*)d = pack8(a0, b0); *(u32x4*)(d + 128) = pack8(a1, b1);
            row_part_store(sumsq8(a0, b0) + sumsq8(a1, b1), pcq + (size_t)row * 8 + wc); }
        else { *(u32x4*)(cq + (size_t)row * 384 + (col - 768)) = pack8(a0, b0);
            row_part_store(sumsq8(a0, b0), pcq + (size_t)row * 8 + 4 + wc);
            if (wc == 0) *(u32x4*)(kr + (size_t)row * 32 + (col - 1024)) = pack8(a1, b1); }
    } };
template <int NSLOT> struct FScaled { typedef PreRs RowPre; static constexpr int BATCH = 4; static constexpr bool USE_TAB = false;
    bf16* O; int ldc; const float* part; float inv_k;
    __device__ __forceinline__ float table_val(int, int, int) const { return 0.f; }
    __device__ __forceinline__ Pre4 pre_col(int) const { return Pre4{}; }
    __device__ __forceinline__ RowPre pre_row(int row, int) const { const float ss = NSLOT == 8 ? sum8(part + (size_t)row * 8) : sum4(part + (size_t)row * 4); return PreRs{rsqrtf(ss * inv_k + EPS)}; }
    __device__ __forceinline__ void apply(int row, int col, float, const Pre4&, const RowPre& rp, f32x4 a0, f32x4 b0, f32x4 a1, f32x4 b1) const {
        const float rs = rp.rs; bf16* d = O + (size_t)row * ldc + col; *(u32x4*)d = pack8(a0 * rs, b0 * rs); *(u32x4*)(d + 128) = pack8(a1 * rs, b1 * rs);
    } };
struct FVt { typedef NoPre RowPre; static constexpr int BATCH = 4; static constexpr bool USE_TAB = false;
    bf16* Vt; const float* pckv;
    __device__ __forceinline__ float table_val(int, int, int) const { return 0.f; }
    __device__ __forceinline__ Pre4 pre_col(int col) const { Pre4 p;
#pragma unroll
        for (int i = 0; i < 4; ++i) { p.v[0][i] = rsqrtf(sum4(pckv + (size_t)(col + i) * 4) * (1.f / 256.f) + EPS); p.v[1][i] = rsqrtf(sum4(pckv + (size_t)(col + 4 + i) * 4) * (1.f / 256.f) + EPS);
            p.v[2][i] = rsqrtf(sum4(pckv + (size_t)(col + 128 + i) * 4) * (1.f / 256.f) + EPS); p.v[3][i] = rsqrtf(sum4(pckv + (size_t)(col + 132 + i) * 4) * (1.f / 256.f) + EPS); }
        return p; }
    __device__ __forceinline__ RowPre pre_row(int, int) const { return NoPre{}; }
    __device__ __forceinline__ void apply(int row, int col, float, const Pre4& cp, const RowPre&, f32x4 a0, f32x4 b0, f32x4 a1, f32x4 b1) const {
        const int bb = col >> 13, s = col & 8191;
        bf16* d = Vt + ((size_t)(bb * 512 + row) * 8192 + s);
        *(u32x4*)d = pack8(a0 * cp.v[0], b0 * cp.v[1]); *(u32x4*)(d + 128) = pack8(a1 * cp.v[2], b1 * cp.v[3]);
    } };
struct FGates { typedef NoPre RowPre; static constexpr int BATCH = 2; static constexpr bool USE_TAB = true;
    bf16* G; const float* px; const float* bias;
    __device__ __forceinline__ float table_val(int pm, int pn, int t) const { return t < 256 ? rsqrtf(sum16(px + (size_t)(pm * 256 + t) * 16) * (1.f / 1024.f) + EPS) : bias[pn * 256 + t - 256]; }
    __device__ __forceinline__ Pre4 pre_col(int) const { return Pre4{}; }
    __device__ __forceinline__ RowPre pre_row(int, int) const { return NoPre{}; }
    __device__ __forceinline__ void apply(int row, int col, float rs, const Pre4& cp, const RowPre&, f32x4 a0, f32x4 b0, f32x4 a1, f32x4 b1) const {
#pragma unroll
        for (int i = 0; i < 4; ++i) { a0[i] = sigmoidf_(a0[i] * rs + cp.v[0][i]); b0[i] = sigmoidf_(b0[i] * rs + cp.v[1][i]); a1[i] = sigmoidf_(a1[i] * rs + cp.v[2][i]); b1[i] = sigmoidf_(b1[i] * rs + cp.v[3][i]); }
        bf16* d = G + (size_t)row * 2048 + col; *(u32x4*)d = pack8(a0, b0); *(u32x4*)(d + 128) = pack8(a1, b1);
    } };
struct FGlu { typedef PreU2 RowPre; static constexpr int BATCH = 4; static constexpr bool USE_TAB = false;
    bf16* Y; const bf16* yg; const float* bias;
    __device__ __forceinline__ float table_val(int, int, int) const { return 0.f; }
    __device__ __forceinline__ Pre4 pre_col(int col) const { Pre4 p; p.v[0] = *(const f32x4*)(bias + col); p.v[1] = *(const f32x4*)(bias + col + 4); p.v[2] = *(const f32x4*)(bias + col + 128); p.v[3] = *(const f32x4*)(bias + col + 132); return p; }
    __device__ __forceinline__ RowPre pre_row(int row, int col) const { const bf16* s = yg + ((size_t)(col >> 4) * NTOK + row) * 16 + (col & 15); return PreU2{*(const u32x4*)s, *(const u32x4*)(s + (size_t)8 * NTOK * 16)}; }
    __device__ __forceinline__ void apply(int row, int col, float, const Pre4& cp, const RowPre& rp, f32x4 a0, f32x4 b0, f32x4 a1, f32x4 b1) const {
        f32x4 y0, y1, y2, y3; unpack8(rp.a, y0, y1); unpack8(rp.b, y2, y3);
#pragma unroll
        for (int i = 0; i < 4; ++i) { a0[i] = y0[i] * sigmoidf_(a0[i] + cp.v[0][i]); b0[i] = y1[i] * sigmoidf_(b0[i] + cp.v[1][i]); a1[i] = y2[i] * sigmoidf_(a1[i] + cp.v[2][i]); b1[i] = y3[i] * sigmoidf_(b1[i] + cp.v[3][i]); }
        bf16* d = Y + (size_t)row * 512 + col; *(u32x4*)d = pack8(a0, b0); *(u32x4*)(d + 128) = pack8(a1, b1);
    } };
template <bool SECOND> struct FOut { typedef PreU4 RowPre; static constexpr int BATCH = SECOND ? 2 : 4; static constexpr bool USE_TAB = false;
    bf16* M; const bf16* G;
    __device__ __forceinline__ float table_val(int, int, int) const { return 0.f; }
    __device__ __forceinline__ Pre4 pre_col(int) const { return Pre4{}; }
    __device__ __forceinline__ RowPre pre_row(int row, int col) const { PreU4 p; const bf16* g = G + (size_t)row * 2048 + (SECOND ? 1024 : 0) + col; p.a = *(const u32x4*)g; p.b = *(const u32x4*)(g + 128);
        if (SECOND) { const bf16* mm = M + (size_t)row * 1024 + col; p.c = *(const u32x4*)mm; p.d = *(const u32x4*)(mm + 128); } else { p.c = p.a; p.d = p.b; } return p; }
    __device__ __forceinline__ void apply(int row, int col, float, const Pre4&, const RowPre& rp, f32x4 a0, f32x4 b0, f32x4 a1, f32x4 b1) const {
        f32x4 g0, g1, g2, g3; unpack8(rp.a, g0, g1); unpack8(rp.b, g2, g3);
        a0 = a0 * g0; b0 = b0 * g1; a1 = a1 * g2; b1 = b1 * g3;
        if (SECOND) { f32x4 m0, m1, m2, m3; unpack8(rp.c, m0, m1); unpack8(rp.d, m2, m3); a0 = a0 + m0; b0 = b0 + m1; a1 = a1 + m2; b1 = b1 + m3; }
        bf16* d = M + (size_t)row * 1024 + col; *(u32x4*)d = pack8(a0, b0); *(u32x4*)(d + 128) = pack8(a1, b1);
    } };
struct FOutChain { typedef PreU2 RowPre; static constexpr int BATCH = 4; static constexpr bool USE_TAB = false;
    bf16* M; const bf16* G;
    __device__ __forceinline__ float table_val(int, int, int) const { return 0.f; }
    __device__ __forceinline__ Pre4 pre_col(int) const { return Pre4{}; }
    __device__ __forceinline__ PreU4 mid_pre(int row, int col) const { const bf16* g = G + (size_t)row * 2048 + col; PreU4 p; p.a = *(const u32x4*)g; p.b = *(const u32x4*)(g + 128); p.c = *(const u32x4*)(g + 1024); p.d = *(const u32x4*)(g + 1024 + 128); return p; }
    __device__ __forceinline__ void mid_apply(const PreU4& rp, f32x4& a0, f32x4& b0, f32x4& a1, f32x4& b1) const {
        f32x4 g0, g1, g2, g3, h0, h1, h2, h3; unpack8(rp.a, g0, g1); unpack8(rp.b, g2, g3); unpack8(rp.c, h0, h1); unpack8(rp.d, h2, h3);
#pragma unroll
        for (int i = 0; i < 4; ++i) { a0[i] *= g0[i] * __builtin_amdgcn_rcpf(h0[i]); b0[i] *= g1[i] * __builtin_amdgcn_rcpf(h1[i]); a1[i] *= g2[i] * __builtin_amdgcn_rcpf(h2[i]); b1[i] *= g3[i] * __builtin_amdgcn_rcpf(h3[i]); }
    }
    __device__ __forceinline__ RowPre pre_row(int row, int col) const { const bf16* g = G + (size_t)row * 2048 + 1024 + col; return PreU2{*(const u32x4*)g, *(const u32x4*)(g + 128)}; }
    __device__ __forceinline__ void apply(int row, int col, float, const Pre4&, const RowPre& rp, f32x4 a0, f32x4 b0, f32x4 a1, f32x4 b1) const {
        f32x4 h0, h1, h2, h3; unpack8(rp.a, h0, h1); unpack8(rp.b, h2, h3);
        bf16* d = M + (size_t)row * 1024 + col; *(u32x4*)d = pack8(a0 * h0, b0 * h1); *(u32x4*)(d + 128) = pack8(a1 * h2, b1 * h3);
    } };
template <> struct IsChainF<FOutChain> { static constexpr bool v = true; };
struct FResid { typedef Pre4 RowPre; static constexpr int BATCH = 4; static constexpr bool USE_TAB = false;
    const float* xold; float* out; bf16* xb; float* part_next;
    __device__ __forceinline__ float table_val(int, int, int) const { return 0.f; }
    __device__ __forceinline__ Pre4 pre_col(int) const { return Pre4{}; }
    __device__ __forceinline__ RowPre pre_row(int row, int col) const { const float* s = xold + (size_t)row * 1024 + col; Pre4 p; p.v[0] = *(const f32x4*)s; p.v[1] = *(const f32x4*)(s + 4); p.v[2] = *(const f32x4*)(s + 128); p.v[3] = *(const f32x4*)(s + 132); return p; }
    __device__ __forceinline__ void apply(int row, int col, float, const Pre4&, const RowPre& rp, f32x4 a0, f32x4 b0, f32x4 a1, f32x4 b1) const {
        const size_t o = (size_t)row * 1024 + col;
        a0 = a0 + rp.v[0]; b0 = b0 + rp.v[1]; a1 = a1 + rp.v[2]; b1 = b1 + rp.v[3];
        *(f32x4*)(out + o) = a0; *(f32x4*)(out + o + 4) = b0; *(f32x4*)(out + o + 128) = a1; *(f32x4*)(out + o + 132) = b1;
        *(u32x4*)(xb + o) = pack8(a0, b0); *(u32x4*)(xb + o + 128) = pack8(a1, b1);
        if (part_next) row_part_store(sumsq8(a0, b0) + sumsq8(a1, b1), part_next + (size_t)row * 16 + (col >> 8) * 4 + ((col >> 5) & 3));
    } };
struct FFf1 { typedef NoPre RowPre; static constexpr int BATCH = 2; static constexpr bool USE_TAB = true;
    bf16* Hd; const float* px;
    __device__ __forceinline__ float table_val(int pm, int, int t) const { return t < 256 ? rsqrtf(sum16(px + (size_t)(pm * 256 + t) * 16) * (1.f / 1024.f) + EPS) : 0.f; }
    __device__ __forceinline__ Pre4 pre_col(int) const { return Pre4{}; }
    __device__ __forceinline__ RowPre pre_row(int, int) const { return NoPre{}; }
    __device__ __forceinline__ void apply(int row, int col, float rs, const Pre4&, const RowPre&, f32x4 a0, f32x4 b0, f32x4 a1, f32x4 b1) const {
#pragma unroll
        for (int i = 0; i < 4; ++i) { float t = fmaxf(a0[i] * rs, 0.f); a0[i] = t * t; t = fmaxf(b0[i] * rs, 0.f); b0[i] = t * t; t = fmaxf(a1[i] * rs, 0.f); a1[i] = t * t; t = fmaxf(b1[i] * rs, 0.f); b1[i] = t * t; }
        bf16* d = Hd + (size_t)row * 4096 + col; *(u32x4*)d = pack8(a0, b0); *(u32x4*)(d + 128) = pack8(a1, b1);
    } };

struct FNull { typedef NoPre RowPre; static constexpr int BATCH = 8; static constexpr bool USE_TAB = false;
    __device__ __forceinline__ float table_val(int, int, int) const { return 0.f; }
    __device__ __forceinline__ Pre4 pre_col(int) const { return Pre4{}; }
    __device__ __forceinline__ RowPre pre_row(int, int) const { return NoPre{}; }
    __device__ __forceinline__ void apply(int, int, float, const Pre4&, const RowPre&, f32x4 a0, f32x4 b0, f32x4 a1, f32x4 b1) const { asm volatile("" :: "v"(a0), "v"(b0), "v"(a1), "v"(b1)); } };
template <class F> __device__ __forceinline__ void run_gemm(LAS unsigned char* lds, int wv, const bf16* A, const bf16* Bt, int M, int N, int K, const F& f, int a_gm = 0) {
    pg8::Gemm g{A, Bt, M, N, K, a_gm, nullptr, nullptr};
    pg8::StaticOrder so; so.init(M, N, (int)gridDim.x, (int)blockIdx.x);
    HookSched<F> S{so, f, lds, wv, false};
    EpiRow8<F> E{f, lds};
    pg8::gemm_phase<EpiRow8<F>, HookSched<F>, true, true>(lds, g, S, E, opaque_tid(wv));
    __syncthreads();
}

template <class F> __device__ __forceinline__ void run_gemm_chain(LAS unsigned char* lds, int wv, const bf16* A, const bf16* Bt, const bf16* A2, const bf16* Bt2, int M, int N, int K, const F& f) {
    pg8::Gemm g{A, Bt, M, N, K, 0, A2, Bt2};
    pg8::StaticOrder so; so.init(M, N, (int)gridDim.x, (int)blockIdx.x);
    HookSched<F> S{so, f, lds, wv, true};
    EpiRow8<F> E{f, lds};
    pg8::gemm_phase<EpiRow8<F>, HookSched<F>, true, true>(lds, g, S, E, opaque_tid(wv));
    __syncthreads();
}

struct TrJob { const float* src; const float* gain; bf16* dst; int ldw, dstK; };
__device__ __forceinline__ void tr_load(const TrJob& j, int lane, f32x4 (&v)[8]) {
#pragma unroll
    for (int i = 0; i < 8; ++i) { const int kk = 8 * i + (lane >> 3), nn = 4 * (lane & 7); v[i] = *(const f32x4*)(j.src + (size_t)kk * j.ldw + nn); if (j.gain) v[i] = v[i] * j.gain[kk]; }
}
__device__ __forceinline__ void tr_finish(const TrJob& j, int lane, const f32x4 (&v)[8], LAS float* scr) {
#pragma unroll
    for (int i = 0; i < 8; ++i) { const int kk = 8 * i + (lane >> 3), nn = 4 * (lane & 7); scr[kk * 33 + nn] = v[i][0]; scr[kk * 33 + nn + 1] = v[i][1]; scr[kk * 33 + nn + 2] = v[i][2]; scr[kk * 33 + nn + 3] = v[i][3]; }
    asm volatile("s_waitcnt lgkmcnt(0)" ::: "memory");
    const int c = lane & 7;
#pragma unroll
    for (int jj = 0; jj < 4; ++jj) { const int n = (lane >> 3) + 8 * jj; const LAS float* s = scr + (8 * c) * 33 + n;
        u32x4 o; o.x = pk2(s[0 * 33], s[1 * 33]); o.y = pk2(s[2 * 33], s[3 * 33]); o.z = pk2(s[4 * 33], s[5 * 33]); o.w = pk2(s[6 * 33], s[7 * 33]);
        *(u32x4*)(j.dst + (size_t)n * j.dstK + 8 * c) = o; }
    asm volatile("s_waitcnt lgkmcnt(0)" ::: "memory");
}

struct Params { const float* in[26]; float* out; unsigned char* ws; int ph_lo, ph_hi; };

constexpr int TI_IN = 16 * 101, TI_Q = 6 * 24, TI_KV = 4 * 32, TI_GLU = 8 * 16, TI_OS = 8 * 32, TI_OM = 8 * 32, TI_O = 16 * 32, TI_1 = 16 * 128, TI_2 = 64 * 32;
constexpr int TI_L = TI_IN + TI_Q + TI_KV + TI_GLU + TI_OS + TI_OM + TI_O + TI_1 + TI_2;
__device__ __forceinline__ TrJob tr_decode(const Params& P, int it) {
    const int l = it / TI_L; int r = it % TI_L;
    unsigned char* wl = P.ws + WS_W + (size_t)l * W_STRIDE;
    const float* W; const float* gain = nullptr; bf16* dst; int ldw, dstK, k0, n0, drow;
    if (r < TI_IN) { const int kb = r / 101, nb = r % 101; n0 = 32 * nb; k0 = 64 * kb; W = P.in[2] + (size_t)l * 1024 * 3232; ldw = 3232; gain = P.in[1] + l * 1024; dstK = 1024; dst = (bf16*)(wl + WO_INS);
        if (n0 < 512) drow = n0; else if (n0 < 896) drow = 768 + (n0 - 512); else if (n0 < 1152) drow = 512 + (n0 - 896); else if (n0 < 1184) drow = 1152; else { dst = (bf16*)(wl + WO_G); drow = n0 - 1184; } }
    else if ((r -= TI_IN) < TI_Q) { const int kb = r / 24, nb = r % 24; n0 = 32 * nb; k0 = 64 * kb; W = P.in[17] + (size_t)l * 384 * 768; ldw = 768; gain = P.in[15] + l * 384; dst = (bf16*)(wl + WO_Q); dstK = 384; drow = n0; }
    else if ((r -= TI_Q) < TI_KV) { const int kb = r / 32, nb = r % 32; n0 = 32 * nb; k0 = 64 * kb; const int h = n0 >> 7, w = n0 & 127; W = P.in[18] + (size_t)l * 256 * 1024; ldw = 1024; gain = P.in[16] + l * 256;
        dst = (bf16*)(wl + (w < 64 ? WO_KN : WO_V)); dstK = 256; drow = h * 64 + (w & 63); }
    else if ((r -= TI_KV) < TI_GLU) { const int kb = r / 16, nb = r % 16; n0 = 32 * nb; k0 = 64 * kb; W = P.in[12] + (size_t)l * 512 * 512; ldw = 512; dst = (bf16*)(wl + WO_GLU); dstK = 512; drow = n0; }
    else if ((r -= TI_GLU) < TI_OS) { const int kb = r / 32, nb = r % 32; n0 = 32 * nb; k0 = 64 * kb; W = P.in[14] + (size_t)l * 512 * 1024; ldw = 1024; dst = (bf16*)(wl + WO_OS); dstK = 512; drow = n0; }
    else if ((r -= TI_OS) < TI_OM) { const int kb = r / 32, nb = r % 32; n0 = 32 * nb; k0 = 64 * kb; W = P.in[21] + (size_t)l * 512 * 1024; ldw = 1024; dst = (bf16*)(wl + WO_OM); dstK = 512; drow = n0; }
    else if ((r -= TI_OM) < TI_O) { const int kb = r / 32, nb = r % 32; n0 = 32 * nb; k0 = 64 * kb; W = P.in[22] + (size_t)l * 1024 * 1024; ldw = 1024; dst = (bf16*)(wl + WO_O); dstK = 1024; drow = n0; }
    else if ((r -= TI_O) < TI_1) { const int kb = r / 128, nb = r % 128; n0 = 32 * nb; k0 = 64 * kb; W = P.in[24] + (size_t)l * 1024 * 4096; ldw = 4096; gain = P.in[23] + l * 1024; dst = (bf16*)(wl + WO_1); dstK = 1024; drow = n0; }
    else { r -= TI_1; const int kb = r / 32, nb = r % 32; n0 = 32 * nb; k0 = 64 * kb; W = P.in[25] + (size_t)l * 4096 * 1024; ldw = 1024; dst = (bf16*)(wl + WO_2); dstK = 4096; drow = n0; }
    TrJob j; j.src = W + (size_t)k0 * ldw + n0; j.gain = gain ? gain + k0 : nullptr; j.dst = dst + (size_t)drow * dstK + k0; j.ldw = ldw; j.dstK = dstK; return j;
}

__device__ __forceinline__ void prologue(const Params& P, LAS unsigned char* lds, const int tid) {
    const int lane = tid & 63, wave = tid >> 6;
    const int gw = blockIdx.x * NWAVES + wave, NGW = gridDim.x * NWAVES;
    const int gt = blockIdx.x * NTHREADS + tid, NGT = gridDim.x * NTHREADS;
    unsigned char* ws = P.ws;
    LAS float* scr = (LAS float*)(lds + wave * 8704);
    { int it = gw; f32x4 va[8], vb[8]; TrJob ja, jb;
      if (it < DEPTH * TI_L) { ja = tr_decode(P, it); tr_load(ja, lane, va); }
      while (it < DEPTH * TI_L) {
          const int it2 = it + NGW; const bool m2 = it2 < DEPTH * TI_L;
          if (m2) { jb = tr_decode(P, it2); tr_load(jb, lane, vb); }
          tr_finish(ja, lane, va, scr);
          if (!m2) break;
          const int it3 = it2 + NGW; const bool m3 = it3 < DEPTH * TI_L;
          if (m3) { ja = tr_decode(P, it3); tr_load(ja, lane, va); }
          tr_finish(jb, lane, vb, scr);
          if (!m3) break;
          it = it3;
      } }
    for (int i = gt; i < DEPTH * 96 * 128; i += NGT) { const int l = i / (96 * 128), r = i % (96 * 128);
        ((u32x4*)(ws + WS_W + (size_t)l * W_STRIDE + WO_INS + (size_t)1184 * 1024 * 2))[r] = (u32x4){0u, 0u, 0u, 0u}; }
    { const float* x = P.in[0]; bf16* xb = (bf16*)(ws + WS_XB); float* pxm = (float*)(ws + WS_PXM);
      for (int m = gw; m < NTOK; m += NGW) { const f32x4* xr = (const f32x4*)(x + (size_t)m * DM) + lane; float s = 0.f; u32x2* o8 = (u32x2*)(xb + (size_t)m * DM) + lane;
#pragma unroll
          for (int j = 0; j < 4; ++j) { const f32x4 v = xr[64 * j]; s += (v[0] * v[0] + v[1] * v[1]) + (v[2] * v[2] + v[3] * v[3]); u32x2 w; w.x = pk2(v[0], v[1]); w.y = pk2(v[2], v[3]); o8[64 * j] = w; }
          s = wave_sum(s); if (lane < 16) pxm[(size_t)m * 16 + lane] = lane == 0 ? s : 0.f; } }
    { float* smw = (float*)(ws + WS_SMALL);
      for (int i = gt; i < SM_END; i += NGT) { float v;
          if (i < SM_CIM) v = P.in[9][i]; else if (i < SM_BG) v = P.in[10][i - SM_CIM]; else if (i < SM_BGLU) v = P.in[3][i - SM_BG]; else if (i < SM_DD) v = P.in[13][i - SM_BGLU];
          else if (i < SM_QG) v = P.in[11][i - SM_DD]; else if (i < SM_KG) v = P.in[19][i - SM_QG]; else v = P.in[20][i - SM_KG];
          smw[i] = v; } }
    { f32x2* ptab = (f32x2*)(ws + WS_PTAB);
      for (int i = gt; i < DEPTH * NG * 2 * NS * 65; i += NGT) { const int e = i % 65, idx = i / 65;
          const int n = idx & 63, dir = (idx >> 6) & 1, g = (idx >> 7) & 31, l = idx >> 12;
          const int pi = ((l * 2 + dir) * NG + g) * NS + n;
          const double lr = (double)P.in[4][pi], li = (double)P.in[5][pi], st = exp((double)P.in[6][(l * 2 + dir) * NG + g]);
          const double ang = li * st * (double)e, kq = rint(ang * 0.15915494309189535), rr = (ang - kq * 6.283185307179586) - kq * 2.4492935982947064e-16;
          const float mag = expf((float)(lr * st * (double)e)); float sn, cs; sincosf((float)rr, &sn, &cs);
          ptab[i] = (f32x2){mag * cs, mag * sn}; }
      f32x2* bbar = (f32x2*)(ws + WS_BBAR);
      for (int i = gt; i < DEPTH * NG * 2 * NS * NP; i += NGT) { const int q = i & 15, idx = i >> 4;
          const int n = idx & 63, dir = (idx >> 6) & 1, g = (idx >> 7) & 31, l = idx >> 12;
          const int pi = ((l * 2 + dir) * NG + g) * NS + n;
          const double lr = (double)P.in[4][pi], li = (double)P.in[5][pi], st = exp((double)P.in[6][(l * 2 + dir) * NG + g]);
          const double mag = exp(lr * st), ar = mag * cos(li * st), ai = mag * sin(li * st);
          const double nr = ar - 1.0, ni = ai, den = lr * lr + li * li, fr = (nr * lr + ni * li) / den, fi = (ni * lr - nr * li) / den;
          const double br = (double)P.in[7][(size_t)pi * NP + q], bi = (double)P.in[8][(size_t)pi * NP + q];
          bbar[i] = (f32x2){(float)(fr * br - fi * bi), (float)(fr * bi + fi * br)}; } }
    { f32x2* rope = (f32x2*)(ws + WS_ROPE);
      for (int i = gt; i < SEQ * 16; i += NGT) { const int s = i >> 4, j = i & 15; const float inv = powf(10000.f, -(float)j / 16.f); const float ang = (float)s * inv;
          rope[i] = (f32x2){(float)cos((double)ang), (float)sin((double)ang)}; } }
}

__device__ __forceinline__ void ssm_tables(unsigned char* ws, int l, const int tid) {
    const int gt = blockIdx.x * NTHREADS + tid, NGT = gridDim.x * NTHREADS;
    const f32x2* ptab = (const f32x2*)(ws + WS_PTAB) + (size_t)l * NG * 2 * NS * 65;
    const f32x2* bbar = (const f32x2*)(ws + WS_BBAR) + (size_t)l * NG * 2 * NS * NP;
    const float* cre = (const float*)(ws + WS_SMALL) + SM_CRE + (size_t)l * NG * NP * NS; const float* cim = (const float*)(ws + WS_SMALL) + SM_CIM + (size_t)l * NG * NP * NS;
    bf16* WA = (bf16*)(ws + WS_WA); bf16* WC = (bf16*)(ws + WS_WC); bf16* Kt = (bf16*)(ws + WS_KT);
    for (int it = gt; it < NG * 2 * NS * LCH; it += NGT) { const int i = it & 63, n = (it >> 6) & 63, dir = (it >> 12) & 1, g = it >> 13;
        const int pb = (g * 2 + dir) * NS + n; const f32x2 pw = ptab[(size_t)pb * 65 + (dir ? i : 63 - i)];
        unsigned re[8], im[8];
#pragma unroll
        for (int q = 0; q < 16; q += 2) { const f32x2 b0 = bbar[(size_t)pb * NP + q], b1 = bbar[(size_t)pb * NP + q + 1];
            re[q >> 1] = pk2(pw.x * b0.x - pw.y * b0.y, pw.x * b1.x - pw.y * b1.y); im[q >> 1] = pk2(pw.x * b0.y + pw.y * b0.x, pw.x * b1.y + pw.y * b1.x); }
        bf16* r0 = WA + ((size_t)(g * 256 + dir * 128 + 2 * n) * 1024 + i * 16);
        *(u32x4*)(r0) = (u32x4){re[0], re[1], re[2], re[3]}; *(u32x4*)(r0 + 8) = (u32x4){re[4], re[5], re[6], re[7]};
        *(u32x4*)(r0 + 1024) = (u32x4){im[0], im[1], im[2], im[3]}; *(u32x4*)(r0 + 1024 + 8) = (u32x4){im[4], im[5], im[6], im[7]}; }
#pragma unroll 4
    for (int it = gt; it < NG * LCH * NP * 2 * NS; it += NGT) { const int n = it & 63, dir = (it >> 6) & 1, p = (it >> 7) & 15, i = (it >> 11) & 63, g = it >> 17;
        const f32x2 pw = ptab[(size_t)((g * 2 + dir) * NS + n) * 65 + (dir ? 64 - i : i + 1)];
        const float cr = cre[(g * NP + p) * NS + n], ci = cim[(g * NP + p) * NS + n];
        ((unsigned*)WC)[((size_t)(g * 1024 + i * 16 + p) * 256 + dir * 128 + 2 * n) >> 1] = pk2(cr * pw.x - ci * pw.y, -(cr * pw.y + ci * pw.x)); }
}
__device__ __forceinline__ void ssm_kt_task(unsigned char* ws, LAS unsigned char* lds, int l, int task, int tid) {
    const int g = task >> 3, lb = task & 7;
    const f32x2* ptab = (const f32x2*)(ws + WS_PTAB) + (size_t)l * NG * 2 * NS * 65;
    const f32x2* bbar = (const f32x2*)(ws + WS_BBAR) + (size_t)l * NG * 2 * NS * NP;
    const float* cre = (const float*)(ws + WS_SMALL) + SM_CRE + (size_t)l * NG * NP * NS; const float* cim = (const float*)(ws + WS_SMALL) + SM_CIM + (size_t)l * NG * NP * NS;
    LAS f32x2* Pl = (LAS f32x2*)lds;
#pragma unroll
    for (int r = 0; r < 4; ++r) { const int c = r * 512 + tid, s = c & 15, n = (c >> 4) & 63, dir = c >> 10; const int d = lb * 16 + s - 63;
        const bool ok = dir == 0 ? (d >= 0) : (d <= 0); const int e = d < 0 ? -d : d;
        f32x2 v = (f32x2){0.f, 0.f}; if (ok && e <= 64) v = ptab[(size_t)((g * 2 + dir) * NS + n) * 65 + e];
        Pl[c] = v; }
    __syncthreads();
    const int pq = tid & 255, p = pq >> 4, q = pq & 15, half = tid >> 8;
    float acc[8];
#pragma unroll
    for (int s = 0; s < 8; ++s) acc[s] = 0.f;
    for (int dir = 0; dir < 2; ++dir) {
        const int dlo = lb * 16 + half * 8 - 63, dhi = dlo + 7;
        if (dir == 0 ? (dhi < 0) : (dlo > 0)) continue;
        const float* cr_ = cre + (g * NP + p) * NS; const float* ci_ = cim + (g * NP + p) * NS; const f32x2* bb = bbar + (size_t)((g * 2 + dir) * NS) * NP + q;
#pragma unroll 8
        for (int n = 0; n < NS; ++n) { const float cr = cr_[n], ci = ci_[n]; const f32x2 b = bb[n * NP];
            const float xr = cr * b.x - ci * b.y, xi = cr * b.y + ci * b.x;
#pragma unroll
            for (int s = 0; s < 8; ++s) { const f32x2 pw = Pl[(dir * 64 + n) * 16 + half * 8 + s]; acc[s] += xr * pw.x - xi * pw.y; } }
    }
    bf16* Kt = (bf16*)(ws + WS_KT);
#pragma unroll
    for (int s = 0; s < 8; ++s) { const int dd = lb * 16 + half * 8 + s; if (dd < 127) Kt[((size_t)(g * 127 + dd) * 16 + p) * 16 + q] = (bf16)f2bf(acc[s]); }
    __syncthreads();
}

constexpr int SS_KT = 0, SS_UB = 65536;
__device__ __forceinline__ void ssm_stage_u(unsigned char* ws, LAS unsigned char* lds, int g, int cb, int hh, int tid) {
    asm volatile("" : "+v"(tid));
    const bf16* U = (const bf16*)(ws + AR_U);
    u32x4 v[8];
#pragma unroll
    for (int r = 0; r < 8; ++r) { const int c = r * 512 + tid, jj = c >> 7, col = (c >> 1) & 63, part = c & 1;
        v[r] = *(const u32x4*)(U + ((size_t)((cb * 64 + col) * 64 + hh * 32 + jj) * 512 + g * 16 + part * 8)); }
#pragma unroll
    for (int r = 0; r < 8; ++r) { const int c = r * 512 + tid; *(LAS u32x4*)(lds + SS_UB + c * 16) = v[r]; }
}
__device__ __forceinline__ void ssm_a_task(unsigned char* ws, LAS unsigned char* lds, int task, int tid) {
    const int lane = tid & 63, wid = tid >> 6, rr = lane & 15, kk = lane >> 4;
    const int g = task >> 3, cb = task & 7;
    f32x4 acc[2][4];
#pragma unroll
    for (int a = 0; a < 2; ++a)
#pragma unroll
        for (int c = 0; c < 4; ++c) acc[a][c] = (f32x4){0.f, 0.f, 0.f, 0.f};
    const bf16* WA = (const bf16*)(ws + WS_WA) + ((size_t)(g * 256 + wid * 32 + rr) * 1024 + 8 * kk);
    for (int hh = 0; hh < 2; ++hh) {
        ssm_stage_u(ws, lds, g, cb, hh, tid);
        __syncthreads();
#pragma unroll 4
        for (int ks = 0; ks < 16; ++ks) {
            bf16x8 bfr[4], afr[2];
#pragma unroll
            for (int a = 0; a < 2; ++a) afr[a] = *(const bf16x8*)(WA + (size_t)a * 16 * 1024 + (hh * 16 + ks) * 32);
#pragma unroll
            for (int c = 0; c < 4; ++c) bfr[c] = *(const LAS bf16x8*)(lds + SS_UB + (((2 * ks + (kk >> 1)) * 64 + c * 16 + rr) * 32 + (kk & 1) * 16));
#pragma unroll
            for (int a = 0; a < 2; ++a)
#pragma unroll
                for (int c = 0; c < 4; ++c) acc[a][c] = __builtin_amdgcn_mfma_f32_16x16x32_bf16(afr[a], bfr[c], acc[a][c], 0, 0, 0);
        }
        __syncthreads();
    }
    float* S = (float*)(ws + AR_S);
#pragma unroll
    for (int a = 0; a < 2; ++a)
#pragma unroll
        for (int c = 0; c < 4; ++c) { const int col = cb * 64 + c * 16 + rr; *(f32x4*)(S + ((size_t)(col * NG + g) * 256 + wid * 32 + a * 16 + 4 * kk)) = acc[a][c]; }
}
template <int PMODE> __device__ __forceinline__ void ssm_c_task(unsigned char* ws, LAS unsigned char* lds, int l, int task, int tid_in) {
    const int tid = tid_in; const int lane = tid & 63, wid = tid >> 6, rr = lane & 15, kk = lane >> 4;
    const int g = task >> 3, cb = task & 7;
    const bf16* U = (const bf16*)(ws + AR_U);
    f32x4 acc[8][4];
#pragma unroll
    for (int a = 0; a < 8; ++a)
#pragma unroll
        for (int c = 0; c < 4; ++c) acc[a][c] = (f32x4){0.f, 0.f, 0.f, 0.f};
    { const u32x4* src = (const u32x4*)((const bf16*)(ws + WS_KT) + (size_t)g * 127 * 256);
#pragma unroll
      for (int r = 0; r < 8; ++r) { const int c = r * 512 + tid; if (c < 127 * 32) *(LAS u32x4*)(lds + SS_KT + c * 16) = src[c]; } }
    for (int hh = 0; hh < 2; ++hh) {
        for (int rs_ = 0; rs_ < PROBE_SC_STAGE; ++rs_) { if (rs_) __syncthreads(); ssm_stage_u(ws, lds, g, cb, hh, tid); }
        __syncthreads();
#if PROBE_SC_MMA
        { f32x4 dac[8][4];
#pragma unroll
          for (int a = 0; a < 8; ++a)
#pragma unroll
            for (int c = 0; c < 4; ++c) dac[a][c] = (f32x4){0.f, 0.f, 0.f, 0.f};
#pragma unroll 2
          for (int ks = 0; ks < 16; ++ks) {
            bf16x8 bfr[4];
#pragma unroll
            for (int c = 0; c < 4; ++c) bfr[c] = *(const LAS bf16x8*)(lds + SS_UB + (((2 * ks + (kk >> 1)) * 64 + c * 16 + rr) * 32 + (kk & 1) * 16));
            const int j = hh * 32 + 2 * ks + (kk >> 1);
#pragma unroll
            for (int a = 0; a < 8; ++a) { const int i = wid * 8 + a;
                const bf16x8 af = *(const LAS bf16x8*)(lds + SS_KT + (i - j + 63) * 512 + rr * 32 + (kk & 1) * 16);
#pragma unroll
                for (int c = 0; c < 4; ++c) dac[a][c] = __builtin_amdgcn_mfma_f32_16x16x32_bf16(af, bfr[c], dac[a][c], 0, 0, 0); }
          }
#pragma unroll
          for (int a = 0; a < 8; ++a)
#pragma unroll
            for (int c = 0; c < 4; ++c) asm volatile("" :: "v"(dac[a][c]));
        }
#endif
#pragma unroll 2
        for (int ks = 0; ks < (PMODE == 3 ? 0 : 16); ++ks) {
            bf16x8 bfr[4];
#pragma unroll
            for (int c = 0; c < 4; ++c) bfr[c] = *(const LAS bf16x8*)(lds + SS_UB + (((2 * ks + (kk >> 1)) * 64 + c * 16 + rr) * 32 + (kk & 1) * 16));
            const int j = hh * 32 + 2 * ks + (kk >> 1);
#pragma unroll
            for (int a = 0; a < 8; ++a) { const int i = wid * 8 + a;
                const bf16x8 af = *(const LAS bf16x8*)(lds + SS_KT + (i - j + 63) * 512 + rr * 32 + (kk & 1) * 16);
#pragma unroll
                for (int c = 0; c < 4; ++c) acc[a][c] = __builtin_amdgcn_mfma_f32_16x16x32_bf16(af, bfr[c], acc[a][c], 0, 0, 0); }
        }
        __syncthreads();
    }
    if (PMODE >= 2) {
#pragma unroll
        for (int a = 0; a < 8; ++a)
#pragma unroll
            for (int c = 0; c < 4; ++c) asm volatile("" :: "v"(acc[a][c]));
        __syncthreads(); return; }
    { const bf16* Hb = (const bf16*)(ws + AR_H); int tid = tid_in; asm volatile("" : "+v"(tid));
      u32x4 v[4];
#pragma unroll
      for (int r = 0; r < 4; ++r) { const int c = r * 512 + tid, col = c & 63, kc = c >> 6; v[r] = *(const u32x4*)(Hb + ((size_t)((cb * 64 + col) * NG + g) * 256 + kc * 8)); }
#pragma unroll
      for (int r = 0; r < 4; ++r) { const int c = r * 512 + tid; *(LAS u32x4*)(lds + SS_UB + c * 16) = v[r]; } }
    __syncthreads();
    { const bf16* WC = (const bf16*)(ws + WS_WC) + ((size_t)(g * 1024 + wid * 128 + rr) * 256 + 8 * kk);
#pragma unroll 1
      for (int ks = 0; ks < 8; ++ks) {
          bf16x8 bfr[4], afr[8];
#pragma unroll
          for (int a = 0; a < 8; ++a) afr[a] = *(const bf16x8*)(WC + (size_t)a * 16 * 256 + ks * 32);
#pragma unroll
          for (int c = 0; c < 4; ++c) bfr[c] = *(const LAS bf16x8*)(lds + SS_UB + (((ks * 4 + kk) * 64 + c * 16 + rr) * 16));
#pragma unroll
          for (int a = 0; a < 8; ++a)
#pragma unroll
              for (int c = 0; c < 4; ++c) acc[a][c] = __builtin_amdgcn_mfma_f32_16x16x32_bf16(afr[a], bfr[c], acc[a][c], 0, 0, 0);
      } }
    __syncthreads();
    if (PMODE == 1) {
#pragma unroll
        for (int a = 0; a < 8; ++a)
#pragma unroll
            for (int c = 0; c < 4; ++c) asm volatile("" :: "v"(acc[a][c]));
        return; }
    int rr_e = rr; asm volatile("" : "+v"(rr_e));
    bf16* yb = (bf16*)(ws + AR_YG) + ((size_t)g * NTOK + (size_t)cb * 4096 + (size_t)rr_e * 64 + wid * 8) * 16 + 4 * kk;
    const f32x4 dv = *(const f32x4*)((const float*)(ws + WS_SMALL) + SM_DD + (size_t)l * NG * NP + g * NP + 4 * kk);
#pragma unroll
    for (int a0 = 0; a0 < 8; a0 += 4) {
        u32x2 uw[4][4];
#pragma unroll
        for (int a = 0; a < 4; ++a)
#pragma unroll
            for (int c = 0; c < 4; ++c) { const int col = cb * 64 + c * 16 + rr_e; const size_t tok = (size_t)col * 64 + wid * 8 + a0 + a; uw[a][c] = *(const u32x2*)(U + tok * 512 + g * 16 + 4 * kk); }
#pragma unroll
        for (int a = 0; a < 4; ++a)
#pragma unroll
            for (int c = 0; c < 4; ++c) { const int col = cb * 64 + c * 16 + rr_e; const size_t tok = (size_t)col * 64 + wid * 8 + a0 + a;
                const f32x4 av = acc[a0 + a][c];
                const float y0 = av[0] + dv[0] * bflo(uw[a][c].x), y1 = av[1] + dv[1] * bfhi(uw[a][c].x), y2 = av[2] + dv[2] * bflo(uw[a][c].y), y3 = av[3] + dv[3] * bfhi(uw[a][c].y);
                u32x2 o; o.x = pk2(gelu_tanh(y0), gelu_tanh(y1)); o.y = pk2(gelu_tanh(y2), gelu_tanh(y3));
                if (PMODE == 4) asm volatile("" :: "v"(o)); else *(u32x2*)(yb + (c * 1024 + a0 + a) * 16) = o; }
        asm volatile("" ::: "memory");
    }
}

__device__ __forceinline__ void ssm_scan(unsigned char* ws, int l, int t) {
    const int n = t & 63, dir = (t >> 6) & 1, g = (t >> 7) & 31, b = t >> 12;
    const f32x2 aL = ((const f32x2*)(ws + WS_PTAB))[(size_t)(((l * NG + g) * 2 + dir) * NS + n) * 65 + 64];
    const float* S = (const float*)(ws + AR_S); unsigned* H = (unsigned*)(ws + AR_H);
    float hr = 0.f, hi = 0.f;
    const size_t off = (size_t)g * 256 + dir * 128 + 2 * n;
#pragma unroll 16
    for (int c = 0; c < NCH; ++c) { const int cc = dir ? NCH - 1 - c : c; const size_t col = (size_t)b * NCH + cc;
        const f32x2 s = *(const f32x2*)(S + col * NG * 256 + off);
        H[(col * NG * 256 + off) >> 1] = pk2(hr, hi);
        const float nr = aL.x * hr - aL.y * hi + s.x, ni = aL.x * hi + aL.y * hr + s.y; hr = nr; hi = ni; }
}

__device__ __forceinline__ void prep_item(unsigned char* ws, int l, int item, const int tid) {
    const int lane = tid & 63, j = lane & 3, pr = lane >> 2, h = pr & 7; const size_t tok = (size_t)item * 2 + (pr >> 3);
    const int s = (int)(tok & 8191);
    bf16* Q = (bf16*)(ws + AR_Q); const bf16* KN = (const bf16*)(ws + AR_KN); const bf16* KR = (const bf16*)(ws + AR_KR); bf16* K = (bf16*)(ws + AR_K);
    const f32x2* rope = (const f32x2*)(ws + WS_ROPE) + (size_t)s * 16;
    const float* qg = (const float*)(ws + WS_SMALL) + SM_QG + l * QKD; const float* kg = (const float*)(ws + WS_SMALL) + SM_KG + l * QKD;
    u32x4 wraw[2][3]; f32x2 csv[8];
#pragma unroll
    for (int c = 0; c < 3; ++c) wraw[0][c] = *(const u32x4*)(Q + tok * 768 + h * 96 + (j + 4 * c) * 8);
#pragma unroll
    for (int c = 0; c < 2; ++c) wraw[1][c] = *(const u32x4*)(KN + tok * 512 + h * 64 + (j + 4 * c) * 8);
    wraw[1][2] = *(const u32x4*)(KR + tok * 32 + j * 8);
#pragma unroll
    for (int e = 0; e < 8; ++e) csv[e] = rope[8 * (j & 1) + e];
#pragma unroll
    for (int which = 0; which < 2; ++which) {
        f32x4 v[3][2];
#pragma unroll
        for (int c = 0; c < 3; ++c) unpack8(wraw[which][c], v[c][0], v[c][1]);
        float ss = 0.f;
#pragma unroll
        for (int c = 0; c < 3; ++c) ss += sumsq8(v[c][0], v[c][1]);
        ss += __shfl_xor(ss, 1); ss += __shfl_xor(ss, 2);
        const float rs = rsqrtf(ss * (1.f / 96.f) + EPS);
        const float* gn = which == 0 ? qg : kg;
#pragma unroll
        for (int c = 0; c < 3; ++c) { const f32x4 g0 = *(const f32x4*)(gn + (j + 4 * c) * 8), g1 = *(const f32x4*)(gn + (j + 4 * c) * 8 + 4); v[c][0] = v[c][0] * rs * g0; v[c][1] = v[c][1] * rs * g1; }
        f32x4 o0, o1;
#pragma unroll
        for (int e = 0; e < 4; ++e) { o0[e] = __shfl_xor(v[2][0][e], 2); o1[e] = __shfl_xor(v[2][1][e], 2); }
#pragma unroll
        for (int e = 0; e < 8; ++e) { const f32x2 cs = csv[e]; const float mine = e < 4 ? v[2][0][e] : v[2][1][e - 4], oth = e < 4 ? o0[e] : o1[e - 4];
            const float r = (j < 2) ? (mine * cs.x - oth * cs.y) : (oth * cs.y + mine * cs.x);
            if (e < 4) v[2][0][e] = r; else v[2][1][e - 4] = r; }
        if (which == 0) { const float sc = 0.10206207261596575f * 1.4426950408889634f;
#pragma unroll
            for (int c = 0; c < 3; ++c) { v[c][0] = v[c][0] * sc; v[c][1] = v[c][1] * sc; } }
        bf16* dst = (which == 0 ? Q : K) + tok * 768 + h * 96;
#pragma unroll
        for (int c = 0; c < 3; ++c) *(u32x4*)(dst + (j + 4 * c) * 8) = pack8(v[c][0], v[c][1]);
    }
}

constexpr int AKP = 208, AVP = 144, AKB = 64 * AKP, AVB = 64 * AVP, ABUF = AKB + AVB;
#define ATT_THR 8.0f
__device__ __forceinline__ float max2f(float a, float b) { return __builtin_amdgcn_fmed3f(a, b, __builtin_inff()); }
typedef __bf16 bf16x2_t __attribute__((ext_vector_type(2)));
__device__ __forceinline__ unsigned cvtpk_s(float lo, float hi) { f32x2 v = {lo, hi}; bf16x2_t b = __builtin_convertvector(v, bf16x2_t); return __builtin_bit_cast(unsigned, b); }
template <bool FIXED> __device__ __forceinline__ void attn_unit(unsigned char* ws, LAS unsigned char* lds, int b, int h, int qb, const int tid, const float sbound) {
    const bf16* Q = (const bf16*)(ws + AR_Q); const bf16* K = (const bf16*)(ws + AR_K); const bf16* Vt = (const bf16*)(ws + AR_VT); bf16* O = (bf16*)(ws + AR_O);
    const int lane = tid & 63, wid = tid >> 6, r32 = lane & 31, hi = lane >> 5;
    const size_t tok0 = (size_t)b * SEQ + qb * 256 + wid * 32;
    bf16x8 qf[6];
#pragma unroll
    for (int st = 0; st < 6; ++st) qf[st] = *(const bf16x8*)(Q + (tok0 + r32) * 768 + h * 96 + st * 16 + hi * 8);
    const int kkey0 = tid / 12, kpart0 = tid % 12, kkey1 = (512 + tid) / 12, kpart1 = (512 + tid) % 12, vd = tid >> 3, vpart = tid & 7;
    const bf16* Kg = K + ((size_t)b * SEQ) * 768 + h * 96;
    const bf16* Vg = Vt + ((size_t)(b * NH + h) * 64) * SEQ;
    const bf16* kp0 = Kg + (size_t)kkey0 * 768 + kpart0 * 8; const bf16* kp1 = Kg + (size_t)kkey1 * 768 + kpart1 * 8; const bf16* vp = Vg + (size_t)vd * SEQ + vpart * 8;
    const int kw0 = kkey0 * AKP + kpart0 * 16, kw1 = kkey1 * AKP + kpart1 * 16, vw = AKB + vd * AVP + vpart * 16;
    const bool has1 = tid < 256;
    u32x4 sk0, sk1 = (u32x4){0u, 0u, 0u, 0u}, sv;
#define ATT_LOAD(t) do { sk0 = *(const u32x4*)(kp0 + (size_t)(t) * 64 * 768); if (has1) sk1 = *(const u32x4*)(kp1 + (size_t)(t) * 64 * 768); sv = *(const u32x4*)(vp + (t) * 64); } while (0)
#define ATT_STORE(boff) do { *(LAS u32x4*)(lds + (boff) + kw0) = sk0; if (has1) *(LAS u32x4*)(lds + (boff) + kw1) = sk1; *(LAS u32x4*)(lds + (boff) + vw) = sv; } while (0)
    ATT_LOAD(0); ATT_STORE(0); ATT_LOAD(1); ATT_STORE(ABUF); ATT_LOAD(2);
    __syncthreads();
    const int pi_r = (r32 & ~12) | ((r32 & 4) << 1) | ((r32 & 8) >> 1);
    const int kro = pi_r * AKP + hi * 16, vro = AKB + r32 * AVP + hi * 16;
    f32x16 o0 = {}, o1 = {}, negm = {};
    float mref = 0.f, lsum = 0.f;
#define ATT_QK(P0, P1, boff) do { bf16x8 ka_[6], kb_[6]; \
        _Pragma("unroll") for (int st = 0; st < 6; ++st) { ka_[st] = *(const LAS bf16x8*)(lds + (boff) + kro + st * 32); kb_[st] = *(const LAS bf16x8*)(lds + (boff) + kro + 32 * AKP + st * 32); } \
        P0 = __builtin_amdgcn_mfma_f32_32x32x16_bf16(ka_[0], qf[0], negm, 0, 0, 0); P1 = __builtin_amdgcn_mfma_f32_32x32x16_bf16(kb_[0], qf[0], negm, 0, 0, 0); \
        _Pragma("unroll") for (int st = 1; st < 6; ++st) { P0 = __builtin_amdgcn_mfma_f32_32x32x16_bf16(ka_[st], qf[st], P0, 0, 0, 0); P1 = __builtin_amdgcn_mfma_f32_32x32x16_bf16(kb_[st], qf[st], P1, 0, 0, 0); } } while (0)
#define ATT_ROWMAX(MX, P0, P1) do { float a_ = max2f(P0[0], P1[0]), b_ = max2f(P0[1], P1[1]), c_ = max2f(P0[2], P1[2]), d_ = max2f(P0[3], P1[3]); \
        _Pragma("unroll") for (int r = 4; r < 16; r += 4) { a_ = max2f(a_, max2f(P0[r], P1[r])); b_ = max2f(b_, max2f(P0[r + 1], P1[r + 1])); c_ = max2f(c_, max2f(P0[r + 2], P1[r + 2])); d_ = max2f(d_, max2f(P0[r + 3], P1[r + 3])); } \
        MX = max2f(max2f(a_, b_), max2f(c_, d_)); { auto rr_ = __builtin_amdgcn_permlane32_swap(__float_as_uint(MX), __float_as_uint(MX), false, false); MX = max2f(__uint_as_float(rr_[0]), __uint_as_float(rr_[1])); } } while (0)
    f32x16 pA0, pA1, pB0, pB1;
    constexpr bool fixed_ref = FIXED;
    if constexpr (FIXED) {
#pragma unroll
        for (int r = 0; r < 16; ++r) negm[r] = -sbound;
    }
    ATT_QK(pA0, pA1, 0);
    if constexpr (!FIXED) { float mx; ATT_ROWMAX(mx, pA0, pA1); mref = mx;
#pragma unroll
      for (int r = 0; r < 16; ++r) { pA0[r] -= mx; pA1[r] -= mx; negm[r] = -mref; } }
#define ATT_STEP(P0, P1, N0, N1, t) do { \
        const int cur_ = ((t) % 3) * ABUF, nx1_ = (((t) + 1) % 3) * ABUF, nx2_ = (((t) + 2) % 3) * ABUF; \
        const bool more1_ = (t) + 1 < SEQ / 64, more2_ = (t) + 2 < SEQ / 64; \
        if (more2_) ATT_STORE(nx2_); \
        if ((t) + 3 < SEQ / 64) ATT_LOAD((t) + 3); \
        float mx_; ATT_ROWMAX(mx_, P0, P1); \
        if (__any(mx_ > ATT_THR)) { const float dl_ = fmaxf(mx_, 0.f); mref += dl_; const float al_ = __builtin_amdgcn_exp2f(-dl_); lsum *= al_; \
            _Pragma("unroll") for (int r = 0; r < 16; ++r) { P0[r] -= dl_; P1[r] -= dl_; o0[r] *= al_; o1[r] *= al_; negm[r] = -mref; } } \
        if (more1_) ATT_QK(N0, N1, nx1_); \
        float ls_ = 0.f; \
        _Pragma("unroll") for (int r = 0; r < 16; ++r) { P0[r] = __builtin_amdgcn_exp2f(P0[r]); P1[r] = __builtin_amdgcn_exp2f(P1[r]); ls_ += P0[r] + P1[r]; } \
        lsum += ls_; \
        bf16x8 pb_[2][2]; \
        _Pragma("unroll") for (int s2 = 0; s2 < 2; ++s2) { u32x4 w0_, w1_; \
            w0_.x = cvtpk_s(P0[8 * s2 + 0], P0[8 * s2 + 1]); w0_.y = cvtpk_s(P0[8 * s2 + 2], P0[8 * s2 + 3]); w0_.z = cvtpk_s(P0[8 * s2 + 4], P0[8 * s2 + 5]); w0_.w = cvtpk_s(P0[8 * s2 + 6], P0[8 * s2 + 7]); \
            w1_.x = cvtpk_s(P1[8 * s2 + 0], P1[8 * s2 + 1]); w1_.y = cvtpk_s(P1[8 * s2 + 2], P1[8 * s2 + 3]); w1_.z = cvtpk_s(P1[8 * s2 + 4], P1[8 * s2 + 5]); w1_.w = cvtpk_s(P1[8 * s2 + 6], P1[8 * s2 + 7]); \
            pb_[0][s2] = __builtin_bit_cast(bf16x8, w0_); pb_[1][s2] = __builtin_bit_cast(bf16x8, w1_); } \
        bf16x8 va_[4], vb_[4]; \
        _Pragma("unroll") for (int i_ = 0; i_ < 4; ++i_) { va_[i_] = *(const LAS bf16x8*)(lds + cur_ + vro + i_ * 32); vb_[i_] = *(const LAS bf16x8*)(lds + cur_ + vro + 32 * AVP + i_ * 32); } \
        _Pragma("unroll") for (int i_ = 0; i_ < 4; ++i_) { \
            o0 = __builtin_amdgcn_mfma_f32_32x32x16_bf16(va_[i_], pb_[i_ >> 1][i_ & 1], o0, 0, 0, 0); o1 = __builtin_amdgcn_mfma_f32_32x32x16_bf16(vb_[i_], pb_[i_ >> 1][i_ & 1], o1, 0, 0, 0); } \
        __syncthreads(); } while (0)
    f32x16 lacc = {};
#if ATT_USE_SCHED
#define SGB(mask, n) __builtin_amdgcn_sched_group_barrier(mask, n, 0)
#define ATT_SCHED() do { SGB(0x100, 4); \
        _Pragma("unroll") for (int i_ = 0; i_ < 8; ++i_) { SGB(0x008, 1); SGB(0x100, 1); SGB(0x400, 4); } \
        _Pragma("unroll") for (int i_ = 0; i_ < 4; ++i_) { SGB(0x008, 1); SGB(0x100, 2); SGB(0x002, 6); } \
        _Pragma("unroll") for (int i_ = 0; i_ < 8; ++i_) { SGB(0x008, 1); SGB(0x002, 4); } } while (0)
#else
#define ATT_SCHED() do {} while (0)
#endif
#define ATT_STEP_FIXED(P0, P1, N0, N1, t) do { \
        const int cur_ = ((t) % 3) * ABUF, nx1_ = (((t) + 1) % 3) * ABUF, nx2_ = (((t) + 2) % 3) * ABUF; \
        const bool more1_ = (t) + 1 < SEQ / 64, more2_ = (t) + 2 < SEQ / 64; \
        if (more2_) ATT_STORE(nx2_); \
        if ((t) + 3 < SEQ / 64) ATT_LOAD((t) + 3); \
        if (more1_) ATT_QK(N0, N1, nx1_); \
        _Pragma("unroll") for (int r = 0; r < 16; ++r) { P0[r] = __builtin_amdgcn_exp2f(P0[r]); P1[r] = __builtin_amdgcn_exp2f(P1[r]); } \
        lacc = lacc + (P0 + P1); \
        bf16x8 pb_[2][2]; \
        _Pragma("unroll") for (int s2 = 0; s2 < 2; ++s2) { u32x4 w0_, w1_; \
            w0_.x = cvtpk_s(P0[8 * s2 + 0], P0[8 * s2 + 1]); w0_.y = cvtpk_s(P0[8 * s2 + 2], P0[8 * s2 + 3]); w0_.z = cvtpk_s(P0[8 * s2 + 4], P0[8 * s2 + 5]); w0_.w = cvtpk_s(P0[8 * s2 + 6], P0[8 * s2 + 7]); \
            w1_.x = cvtpk_s(P1[8 * s2 + 0], P1[8 * s2 + 1]); w1_.y = cvtpk_s(P1[8 * s2 + 2], P1[8 * s2 + 3]); w1_.z = cvtpk_s(P1[8 * s2 + 4], P1[8 * s2 + 5]); w1_.w = cvtpk_s(P1[8 * s2 + 6], P1[8 * s2 + 7]); \
            pb_[0][s2] = __builtin_bit_cast(bf16x8, w0_); pb_[1][s2] = __builtin_bit_cast(bf16x8, w1_); } \
        bf16x8 va_[4], vb_[4]; \
        _Pragma("unroll") for (int i_ = 0; i_ < 4; ++i_) { va_[i_] = *(const LAS bf16x8*)(lds + cur_ + vro + i_ * 32); vb_[i_] = *(const LAS bf16x8*)(lds + cur_ + vro + 32 * AVP + i_ * 32); } \
        _Pragma("unroll") for (int i_ = 0; i_ < 4; ++i_) { \
            o0 = __builtin_amdgcn_mfma_f32_32x32x16_bf16(va_[i_], pb_[i_ >> 1][i_ & 1], o0, 0, 0, 0); o1 = __builtin_amdgcn_mfma_f32_32x32x16_bf16(vb_[i_], pb_[i_ >> 1][i_ & 1], o1, 0, 0, 0); } \
        ATT_SCHED(); \
        __syncthreads(); } while (0)
    if constexpr (FIXED) { for (int kt = 0; kt < SEQ / 64; kt += 2) { ATT_STEP_FIXED(pA0, pA1, pB0, pB1, kt); ATT_STEP_FIXED(pB0, pB1, pA0, pA1, kt + 1); }
#pragma unroll
        for (int r = 0; r < 16; ++r) lsum += lacc[r]; }
    else { for (int kt = 0; kt < SEQ / 64; kt += 2) { ATT_STEP(pA0, pA1, pB0, pB1, kt); ATT_STEP(pB0, pB1, pA0, pA1, kt + 1); } }
#undef ATT_STEP_FIXED
#undef ATT_STEP
#undef ATT_ROWMAX
#undef ATT_QK
#undef ATT_LOAD
#undef ATT_STORE
    lsum += __shfl_xor(lsum, 32);
    const float inv = 1.f / lsum;
    bf16* orow = O + (tok0 + r32) * 512 + h * 64 + 4 * hi;
#pragma unroll
    for (int g4 = 0; g4 < 4; ++g4) {
        u32x2 w; w.x = pk2(o0[4 * g4] * inv, o0[4 * g4 + 1] * inv); w.y = pk2(o0[4 * g4 + 2] * inv, o0[4 * g4 + 3] * inv); *(u32x2*)(orow + 8 * g4) = w;
        w.x = pk2(o1[4 * g4] * inv, o1[4 * g4 + 1] * inv); w.y = pk2(o1[4 * g4 + 2] * inv, o1[4 * g4 + 3] * inv); *(u32x2*)(orow + 32 + 8 * g4) = w;
    }
}

#ifndef EN_P0
#define EN_P0 1
#endif
#ifndef EN_P1
#define EN_P1 1
#endif
#ifndef EN_P2
#define EN_P2 1
#endif
#ifndef EN_P3
#define EN_P3 1
#endif
#ifndef EN_P4
#define EN_P4 1
#endif
#ifndef EN_P5
#define EN_P5 1
#endif
#ifndef EN_P6
#define EN_P6 1
#endif
#ifndef EN_P7
#define EN_P7 1
#endif
#ifndef EN_P8
#define EN_P8 1
#endif
#ifndef EN_P9
#define EN_P9 1
#endif
#ifndef PROBE_ATTN_REPS
#define PROBE_ATTN_REPS 1
#endif
#ifndef PROBE_NULL_GEMM
#define PROBE_NULL_GEMM 0
#endif
#ifndef PROBE_G1_REPS
#define PROBE_G1_REPS 1
#endif
#ifndef PROBE_G2_REPS
#define PROBE_G2_REPS 1
#endif
#ifndef PROBE_G5_REPS
#define PROBE_G5_REPS 1
#endif
#ifndef PROBE_G6_REPS
#define PROBE_G6_REPS 1
#endif
#ifndef PROBE_PRO_REPS
#define PROBE_PRO_REPS 1
#endif
#ifndef PROBE_SYNC_REPS
#define PROBE_SYNC_REPS 1
#endif
#ifndef PROBE_MISC_REPS
#define PROBE_MISC_REPS 1
#endif
#ifndef PROBE_FF1_REPS
#define PROBE_FF1_REPS 1
#endif
#ifndef PROBE_SSMC_REPS
#define PROBE_SSMC_REPS 1
#endif
constexpr int LDS_BYTES = 131072 + 64 + 4096;
constexpr int PH_PER_LAYER = 9, N_PHASES = 1 + DEPTH * PH_PER_LAYER;
#define XB_TMO      128
#define XB_XCNT(j)  (256  + 64 * (j))
#define XB_XSUB(j)  (1280 + 64 * (j))
#define XB_XGEN(j)  (2304 + 64 * (j))
#define XB_TOP      3328
#define XB_TOPGEN   3392
#define XCD_BAR_WORDS 3456
#define XB_SPIN_CAP (1u << 18)

__device__ __forceinline__ unsigned xb_ld(unsigned* p)              { return __hip_atomic_load(p, __ATOMIC_RELAXED, __HIP_MEMORY_SCOPE_AGENT); }
__device__ __forceinline__ unsigned xb_add(unsigned* p, unsigned v) { return __hip_atomic_fetch_add(p, v, __ATOMIC_RELAXED, __HIP_MEMORY_SCOPE_AGENT); }
__device__ __forceinline__ unsigned xb_xcc_id() { return (unsigned)__builtin_amdgcn_s_getreg((3 << 11) | 20) & 0xFu; }
#define XB_SPIN(cond, bar) do { unsigned _sp = 0; while (cond) { __builtin_amdgcn_s_sleep(1); \
    if ((++_sp & 255u) == 0u) { if (xb_ld(&(bar)[XB_TMO])) break; if (_sp > XB_SPIN_CAP) { atomicAdd(&(bar)[XB_TMO], 1u); break; } } } } while (0)

struct XcdBarrier {
    unsigned* bar; unsigned x;
    volatile LAS unsigned* st;
};

__device__ __forceinline__ XcdBarrier xcd_barrier_post(unsigned* bar, volatile LAS unsigned* st, bool t0) {
    XcdBarrier b; b.bar = bar; b.x = xb_xcc_id(); b.st = st;
    if (t0) (void)xb_add(&bar[XB_XCNT(b.x)], 1u);
    return b;
}
__device__ __forceinline__ void xcd_barrier_complete(unsigned* bar, unsigned x, unsigned& nloc, unsigned& nx) {
    const unsigned G = gridDim.x * gridDim.y * gridDim.z;
    unsigned sum, cnt, mine, sp = 0u;
    for (;;) {
        sum = 0u; cnt = 0u; mine = 0u;
#pragma unroll
        for (unsigned j = 0; j < 16; ++j) { const unsigned c = xb_ld(&bar[XB_XCNT(j)]); sum += c; cnt += (c > 0u) ? 1u : 0u; mine = (j == x) ? c : mine; }
        if (sum == G) break;
        __builtin_amdgcn_s_sleep(1);
        if ((++sp & 255u) == 0u) { if (xb_ld(&bar[XB_TMO])) break; if (sp > XB_SPIN_CAP) { atomicAdd(&bar[XB_TMO], 1u); break; } }
    }
    nloc = mine > 0u ? mine : 1u; nx = cnt > 0u ? cnt : 1u;
}

__device__ __forceinline__ void xcd_barrier(const XcdBarrier& b, bool t0) {
    asm volatile("s_waitcnt vmcnt(0)" ::: "memory");
    __syncthreads();
    if (t0) {
        unsigned* bar = b.bar;
        __builtin_amdgcn_s_waitcnt(0);
        unsigned nloc = b.st[0], nx = b.st[1];
        if (nloc == 0u) { xcd_barrier_complete(bar, b.x, nloc, nx); b.st[0] = nloc; b.st[1] = nx; }
        const unsigned old = xb_add(&bar[XB_XSUB(b.x)], 1u);
        const unsigned gen = old / nloc;
        if (old + 1u == (gen + 1u) * nloc) {
            __builtin_amdgcn_fence(__ATOMIC_RELEASE, "agent");
            asm volatile("s_waitcnt vmcnt(0)" ::: "memory");
            const unsigned og = xb_add(&bar[XB_TOP], 1u);
            const unsigned tg = og / nx;
            if (og + 1u == (tg + 1u) * nx) xb_add(&bar[XB_TOPGEN], 1u);
            else XB_SPIN(xb_ld(&bar[XB_TOPGEN]) == tg, bar);
            __builtin_amdgcn_fence(__ATOMIC_ACQUIRE, "agent");
            xb_add(&bar[XB_XGEN(b.x)], 1u);
            asm volatile("s_waitcnt vmcnt(0)" ::: "memory");
        } else {
            XB_SPIN(xb_ld(&bar[XB_XGEN(b.x)]) == gen, bar);
            __builtin_amdgcn_fence(__ATOMIC_ACQUIRE, "agent");
            asm volatile("s_waitcnt vmcnt(0)" ::: "memory");
        }
    }
    __syncthreads();
}


__global__ void __launch_bounds__(NTHREADS) mega_fwd(Params P) {
    extern __shared__ __attribute__((aligned(16))) unsigned char lds_raw[];
    LAS unsigned char* lds = (LAS unsigned char*)lds_raw;
    cg::grid_group grid = cg::this_grid();
    unsigned char* ws = P.ws; float* out = P.out;
    const float* sm = (const float*)(ws + WS_SMALL);
    const int G = gridDim.x, NGW = G * NWAVES;
    const int wv = __builtin_amdgcn_readfirstlane((int)threadIdx.x >> 6);
    const int vcu0 = (G % 8 == 0) ? ((int)blockIdx.x % 8) * (G / 8) + (int)blockIdx.x / 8 : (int)blockIdx.x;
    int ph = 0;
#define PHASE_BEGIN if (ph >= P.ph_lo && ph < P.ph_hi) { const int tid = opaque_tid(wv); int bx = blockIdx.x; asm volatile("" : "+s"(bx)); const int wave = tid >> 6, gw = bx * NWAVES + wave; \
        int vcu = vcu0; asm volatile("" : "+s"(vcu)); (void)gw; (void)vcu; (void)wave;
#define PHASE_END   if (ph + 1 < P.ph_hi) { for (int rs_ = 0; rs_ < PROBE_SYNC_REPS; ++rs_) xcd_barrier(bar, opaque_tid(wv) == 0); } } ++ph;

    {
        const int tid = opaque_tid(wv);
        if (tid < 2) ((volatile LAS unsigned*)(lds + 131072))[tid] = 0u;
        if (blockIdx.x == 0) for (int i = tid; i < XCD_BAR_WORDS; i += NTHREADS) ((unsigned*)(ws + WS_BAR))[i] = 0u;
        for (int rep_ = 0; rep_ < PROBE_PRO_REPS; ++rep_) prologue(P, lds, tid);
        grid.sync();
    }
    XcdBarrier bar = xcd_barrier_post((unsigned*)(ws + WS_BAR), (volatile LAS unsigned*)(lds + 131072), opaque_tid(wv) == 0);
    ++ph;

    for (int l = 0; l < DEPTH; ++l) {
        unsigned char* wl = ws + WS_W + (size_t)l * W_STRIDE;
        float* pxm = (float*)(ws + WS_PXM); float* pxf = (float*)(ws + WS_PXF); float* pcq = (float*)(ws + WS_PCQ); float* pckv = (float*)(ws + WS_PCKV);
        bf16* xb = (bf16*)(ws + WS_XB);
        PHASE_BEGIN
#if EN_P1
            ssm_tables(ws, l, tid);
            if (G == 256) { if (bx >= 128) { for (int t = bx - 128; t < NG * 8; t += 128) ssm_kt_task(ws, lds, l, t, tid); } }
            else { for (int t = vcu; t < NG * 8; t += G) ssm_kt_task(ws, lds, l, t, tid); }
            __syncthreads();
            for (int rg_ = 0; rg_ < PROBE_G1_REPS; ++rg_) run_gemm(lds, wv, xb, (const bf16*)(wl + WO_INS), NTOK, 1280, 1024, FInSmall{pxm, pcq, pckv, (bf16*)(ws + AR_U), (bf16*)(ws + AR_CKV), (bf16*)(ws + AR_CQ), (bf16*)(ws + AR_KR)});
#endif
        PHASE_END
        PHASE_BEGIN
#if EN_P2
#if PROBE_NULL_GEMM == 4
            run_gemm(lds, wv, (const bf16*)(ws + AR_CQ), (const bf16*)(wl + WO_Q), NTOK, 768, 384, FNull{});
            run_gemm(lds, wv, (const bf16*)(ws + AR_CKV), (const bf16*)(wl + WO_KN), NTOK, 512, 256, FNull{});
            run_gemm(lds, wv, (const bf16*)(wl + WO_V), (const bf16*)(ws + AR_CKV), 512, NTOK, 256, FNull{});
#endif
            for (int rg_ = 0; rg_ < PROBE_G2_REPS; ++rg_) {
            run_gemm(lds, wv, (const bf16*)(ws + AR_CQ), (const bf16*)(wl + WO_Q), NTOK, 768, 384, FScaled<8>{(bf16*)(ws + AR_Q), 768, pcq, 1.f / 384.f});
            run_gemm(lds, wv, (const bf16*)(ws + AR_CKV), (const bf16*)(wl + WO_KN), NTOK, 512, 256, FScaled<4>{(bf16*)(ws + AR_KN), 512, pckv, 1.f / 256.f});
            run_gemm(lds, wv, (const bf16*)(wl + WO_V), (const bf16*)(ws + AR_CKV), 512, NTOK, 256, FVt{(bf16*)(ws + AR_VT), pckv}); }
            { const int tid2 = opaque_tid(wv); for (int rep_ = 0; rep_ < PROBE_MISC_REPS; ++rep_) for (int t = vcu; t < NG * 8; t += G) ssm_a_task(ws, lds, t, tid2); }
#endif
        PHASE_END
        PHASE_BEGIN
#if EN_P3
            constexpr int SCAN_WG = NBATCH * NG * 2 * NS / NTHREADS;
            if (bx < SCAN_WG) { const int nsw = G < SCAN_WG ? G : SCAN_WG; for (int rep_ = 0; rep_ < PROBE_MISC_REPS; ++rep_) for (int t = bx * NTHREADS + tid; t < SCAN_WG * NTHREADS; t += nsw * NTHREADS) ssm_scan(ws, l, t); }
            else if (G > SCAN_WG) { for (int it = (bx - SCAN_WG) * NWAVES + wave; it < NTOK / 2; it += (G - SCAN_WG) * NWAVES) prep_item(ws, l, it, tid); }
            if (G <= SCAN_WG) { for (int it = gw; it < NTOK / 2; it += NGW) prep_item(ws, l, it, tid); }
#endif
        PHASE_END
        PHASE_BEGIN
#if EN_P4
            float sbound;
            { const float* qg = sm + SM_QG + l * QKD; const float* kg = sm + SM_KG + l * QKD; float gq = 0.f, gk = 0.f;
              for (int i = 0; i < QKD; ++i) { gq = fmaxf(gq, fabsf(qg[i])); gk = fmaxf(gk, fabsf(kg[i])); }
              sbound = 14.1352f * gq * gk * 1.01f + 0.25f; }
            for (int rep_ = 0; rep_ < PROBE_ATTN_REPS; ++rep_)
            for (int i = 0; i * G + vcu < NBATCH * NH * 32; ++i) { const int unit = i * G + vcu; const int bh = unit >> 5, qb = unit & 31; if (sbound <= 60.f) attn_unit<true>(ws, lds, bh >> 3, bh & 7, qb, tid, sbound); else attn_unit<false>(ws, lds, bh >> 3, bh & 7, qb, tid, sbound); }
            for (int rep_ = 0; rep_ < PROBE_SSMC_REPS; ++rep_)
            { const int tid3 = opaque_tid(wv);
#if PROBE_SC_MODE
              for (int t = vcu; t < NG * 8; t += G) ssm_c_task<PROBE_SC_MODE>(ws, lds, l, t, tid3);
#endif
              for (int rep_ = 0; rep_ < PROBE_SSMC_REPS; ++rep_) for (int t = vcu; t < NG * 8; t += G) ssm_c_task<0>(ws, lds, l, t, tid3); }
#endif
        PHASE_END
        PHASE_BEGIN
#if EN_P5
#if PROBE_NULL_GEMM == 3
            run_gemm(lds, wv, xb, (const bf16*)(wl + WO_G), NTOK, 2048, 1024, FNull{});
            run_gemm(lds, wv, (const bf16*)(ws + AR_YG), (const bf16*)(wl + WO_GLU), NTOK, 512, 512, FNull{}, NTOK);
#endif
            for (int rg_ = 0; rg_ < PROBE_G5_REPS; ++rg_) {
            run_gemm(lds, wv, xb, (const bf16*)(wl + WO_G), NTOK, 2048, 1024, FGates{(bf16*)(ws + AR_GATES), pxm, sm + SM_BG + (size_t)l * 2048});
            run_gemm(lds, wv, (const bf16*)(ws + AR_YG), (const bf16*)(wl + WO_GLU), NTOK, 512, 512, FGlu{(bf16*)(ws + AR_YSSM), (const bf16*)(ws + AR_YG), sm + SM_BGLU + (size_t)l * 512}, NTOK); }
#endif
        PHASE_END
        PHASE_BEGIN
#if EN_P6
#if PROBE_NULL_GEMM == 2
            run_gemm(lds, wv, (const bf16*)(ws + AR_YSSM), (const bf16*)(wl + WO_OS), NTOK, 1024, 512, FNull{});
            run_gemm(lds, wv, (const bf16*)(ws + AR_O), (const bf16*)(wl + WO_OM), NTOK, 1024, 512, FNull{});
#endif
            run_gemm_chain(lds, wv, (const bf16*)(ws + AR_YSSM), (const bf16*)(wl + WO_OS), (const bf16*)(ws + AR_O), (const bf16*)(wl + WO_OM), NTOK, 1024, 512, FOutChain{(bf16*)(ws + AR_MRG), (const bf16*)(ws + AR_GATES)});
#endif
        PHASE_END
        PHASE_BEGIN
#if EN_P7
#if PROBE_NULL_GEMM == 5
            run_gemm(lds, wv, (const bf16*)(ws + AR_MRG), (const bf16*)(wl + WO_O), NTOK, 1024, 1024, FNull{});
#endif
            if (l == 0) run_gemm(lds, wv, (const bf16*)(ws + AR_MRG), (const bf16*)(wl + WO_O), NTOK, 1024, 1024, FResid{P.in[0], out, xb, pxf});
            else run_gemm(lds, wv, (const bf16*)(ws + AR_MRG), (const bf16*)(wl + WO_O), NTOK, 1024, 1024, FResid{out, out, xb, pxf});
#endif
        PHASE_END
        PHASE_BEGIN
#if EN_P8
#if PROBE_NULL_GEMM == 6
            run_gemm(lds, wv, xb, (const bf16*)(wl + WO_1), NTOK, 4096, 1024, FNull{});
#endif
            for (int rep_ = 0; rep_ < PROBE_FF1_REPS; ++rep_) run_gemm(lds, wv, xb, (const bf16*)(wl + WO_1), NTOK, 4096, 1024, FFf1{(bf16*)(ws + AR_HID), pxf});
#endif
        PHASE_END
        PHASE_BEGIN
#if EN_P9
#if PROBE_NULL_GEMM == 1
            run_gemm(lds, wv, (const bf16*)(ws + AR_HID), (const bf16*)(wl + WO_2), NTOK, 1024, 4096, FNull{});
#endif
            run_gemm(lds, wv, (const bf16*)(ws + AR_HID), (const bf16*)(wl + WO_2), NTOK, 1024, 4096, FResid{out, out, xb, l + 1 < DEPTH ? pxm : nullptr});
#endif
        PHASE_END
    }
}

extern "C" void kernel_launch(void* const* d_in, const int* in_sizes, int n_in, void* d_out, int out_size, void* d_ws, size_t ws_size, hipStream_t stream) {
    static int grid = 0;
    if (grid == 0) {
        if (n_in != 26 || ws_size < WS_END) { fprintf(stderr, "kernel_launch: unexpected n_in %d / ws_size %zu (need %zu)\n", n_in, ws_size, (size_t)WS_END); grid = -1; return; }
        int dev = 0, cus = 0, per_cu = 0;
        hipGetDevice(&dev); hipDeviceGetAttribute(&cus, hipDeviceAttributeMultiprocessorCount, dev);
        if (hipFuncSetAttribute((const void*)mega_fwd, hipFuncAttributeMaxDynamicSharedMemorySize, LDS_BYTES) != hipSuccess) { fprintf(stderr, "kernel_launch: hipFuncSetAttribute failed\n"); }
        hipOccupancyMaxActiveBlocksPerMultiprocessor(&per_cu, (const void*)mega_fwd, NTHREADS, LDS_BYTES);
        (void)hipGetLastError();
        if (per_cu < 1) per_cu = 1;
        grid = cus * 1;
        fprintf(stderr, "kernel_launch: cus %d per_cu %d grid %d\n", cus, per_cu, grid);
    }
    if (grid < 0) return;
    Params p{};
    for (int i = 0; i < 26; ++i) p.in[i] = (const float*)d_in[i];
    p.out = (float*)d_out; p.ws = (unsigned char*)d_ws; p.ph_lo = 0; p.ph_hi = N_PHASES;
    void* args[] = {&p};
    hipError_t e = hipLaunchCooperativeKernel((const void*)mega_fwd, dim3(grid), dim3(NTHREADS), args, LDS_BYTES, stream);
    if (e != hipSuccess) fprintf(stderr, "cooperative launch failed: %s (grid %d)\n", hipGetErrorString(e), grid);
}
```

```cpp
#include <hip/hip_runtime.h>
#include <hip/hip_cooperative_groups.h>
#include <cstdio>
#include <cstdint>
namespace cg = cooperative_groups;
namespace pg8 {
#define PG8_LAS __attribute__((address_space(3)))
typedef unsigned short bf16_t;
typedef short bf16x8 __attribute__((ext_vector_type(8)));
typedef float f32x4 __attribute__((ext_vector_type(4)));
typedef unsigned u32x4 __attribute__((ext_vector_type(4)));
constexpr int BM = 256, BK = 64, HALF = 128, HTB = HALF * BK * 2  , STAGE_BYTES = 8 * HTB, NXCD = 8, WGM = 8;

__host__ __device__ __forceinline__ int lds_byte(int r, int c) { const int st = (r >> 4) * 2 + (c >> 5), rr = r & 15, cc = c & 31, ob = rr * 64 + cc * 2; return st * 1024 + (ob ^ (((ob >> 9) & 1) << 5)); }
__host__ __device__ __forceinline__ void stage_rc(int b, int& R, int& C) { const int st = b / 1024, sb = b % 1024, swz = sb ^ (((sb >> 9) & 1) << 5); R = (st >> 1) * 16 + swz / 64; C = (st & 1) * 32 + (swz % 64) / 2; }
__host__ __device__ __forceinline__ int perm32(int rho) { const int n = rho >> 4, i = rho & 15; return 8 * (i >> 2) + 4 * n + (i & 3); }

struct Unit { int pm, pn, ph; };
struct Gemm { const bf16_t* A; const bf16_t* Bt; int M, N, K; int a_gm; const bf16_t* A2; const bf16_t* Bt2; };

struct StaticOrder {
    int nM, nN, nwg, G, c;
    __host__ __device__ void init(int M, int N, int G_, int c_) { nM = M / BM; nN = N / BM; nwg = nM * nN; G = G_; c = c_; }
    __host__ __device__ bool next(int i, Unit& u) const {
        const long L = (long)i * G + c; if (L >= nwg) return false;
        int wgid = (int)L; { const int q = nwg / NXCD, r = nwg % NXCD, xcd = wgid % NXCD, off = wgid / NXCD; wgid = (xcd < r ? xcd * (q + 1) : r * (q + 1) + (xcd - r) * q) + off; }
        const int nig = WGM * nN, gid = wgid / nig, fm = gid * WGM, gsz = (nM - fm) < WGM ? (nM - fm) : WGM;
        u.pm = fm + ((wgid % nig) % gsz); u.pn = (wgid % nig) / gsz; return true;
    }
    __device__ __forceinline__ void a_ready(const Unit&) const {}
    __device__ __forceinline__ void done(const Unit&) const {}
};

__device__ __forceinline__ unsigned cvt_pk_bf16(float lo, float hi) { unsigned r; asm volatile("v_cvt_pk_bf16_f32 %0, %1, %2" : "=v"(r) : "v"(lo), "v"(hi)); return r; }
typedef float f32x2 __attribute__((ext_vector_type(2)));
template <class Epi, class Sched, bool ALIGN_EPI = false, bool SP2 = false>
__device__ __forceinline__ void gemm_phase(PG8_LAS unsigned char* lds, const Gemm g, const Sched& S, const Epi& E, const int tid_in) {
    const int tid = tid_in, wid = __builtin_amdgcn_readfirstlane(tid >> 6), lane = tid & 63, wr = wid >> 2, wc = wid & 3, fr = lane & 15, fq = lane >> 4;
    const int K = g.K, nt = K / BK;
    unsigned voffA[2], voffB[2];
#pragma unroll
    for (int i = 0; i < 2; ++i) { int R, C; stage_rc(tid * 16 + i * 8192, R, C); const int Rb = Epi::PERM ? ((R & ~31) + perm32(R & 31)) : R;
        voffA[i] = g.a_gm ? (unsigned)((C >> 4) * g.a_gm * 32 + R * 32 + (C & 15) * 2) : (unsigned)(R * K + C) * 2u; voffB[i] = (unsigned)(Rb * K + C) * 2u; }
    const size_t kstep = (size_t)(BK * 2);
    const size_t hstep = (size_t)HALF * K * 2;
    const size_t tstep = 2 * hstep;
    const size_t kstepA = g.a_gm ? (size_t)4 * g.a_gm * 32 : kstep, hstepA = g.a_gm ? (size_t)HALF * 32 : hstep, tstepA = 2 * hstepA;
    const unsigned ldsw = (unsigned)wid * 1024u;
    const int aoff = lds_byte(wr * 64 + fr, fq * 8), boff = lds_byte(wc * 32 + fr, fq * 8);
#define PG8_SA(b, h) (((b) * 2 + (h)) * HTB)
#define PG8_SB(b, h) ((4 + (b) * 2 + (h)) * HTB)
#define PG8_STAGE(bufoff, gbase, voff) do { _Pragma("unroll") for (int _i = 0; _i < 2; ++_i) \
        __builtin_amdgcn_global_load_lds((const unsigned*)((const char*)(gbase) + (voff)[_i]), (PG8_LAS unsigned*)(lds + (bufoff) + ldsw + _i * 8192), 16, 0, 0); } while (0)
#define PG8_LDA(dst, b, h) do { _Pragma("unroll") for (int m = 0; m < 4; ++m) _Pragma("unroll") for (int k = 0; k < 2; ++k) dst[m][k] = *(const PG8_LAS bf16x8*)(lds + PG8_SA(b, h) + aoff + m * 2048 + k * 1024); } while (0)
#define PG8_LDB(dst, b, h) do { _Pragma("unroll") for (int n = 0; n < 2; ++n) _Pragma("unroll") for (int k = 0; k < 2; ++k) dst[n][k] = *(const PG8_LAS bf16x8*)(lds + PG8_SB(b, h) + boff + n * 2048 + k * 1024); } while (0)
#define PG8_MMA(ai, bj, At, Bt) do { __builtin_amdgcn_s_setprio(1); _Pragma("unroll") for (int m = 0; m < 4; ++m) _Pragma("unroll") for (int n = 0; n < 2; ++n) _Pragma("unroll") for (int k = 0; k < 2; ++k) \
        acc[ai][bj][m][n] = __builtin_amdgcn_mfma_f32_16x16x32_bf16(Bt[n][k], At[m][k], acc[ai][bj][m][n], 0, 0, 0); __builtin_amdgcn_s_setprio(0); } while (0)
#define PG8_WAIT_V(n) asm volatile("s_waitcnt vmcnt(" #n ")" ::: "memory")
#define PG8_WAIT_L(n) asm volatile("s_waitcnt lgkmcnt(" #n ")" ::: "memory")
#define PG8_BAR __builtin_amdgcn_s_barrier()
#define PG8_SCHED __builtin_amdgcn_sched_barrier(0)
    Unit cur, nxt; int ui = 0;
    if (!S.next(0, cur)) return;
    f32x4 acc[2][2][4][2];
#pragma unroll
    for (int a = 0; a < 2; ++a)
#pragma unroll
        for (int b = 0; b < 2; ++b)
#pragma unroll
            for (int m = 0; m < 4; ++m)
#pragma unroll
                for (int n = 0; n < 2; ++n) acc[a][b][m][n] = (f32x4){0.f, 0.f, 0.f, 0.f};
    bf16x8 At[4][2], B0[2][2], B1[2][2];
    const char* cA = (const char*)((g.A2 && cur.ph) ? g.A2 : g.A) + (size_t)cur.pm * tstepA; const char* cB = (const char*)((g.A2 && cur.ph) ? g.Bt2 : g.Bt) + (size_t)cur.pn * tstep;
    S.a_ready(cur, 0);
    if constexpr (SP2) {
        PG8_STAGE(PG8_SB(0, 0), cB, voffB); PG8_STAGE(PG8_SB(0, 1), cB + hstep, voffB); PG8_STAGE(PG8_SA(0, 0), cA, voffA); PG8_STAGE(PG8_SA(0, 1), cA + hstepA, voffA);
        if (wr == 1) PG8_BAR;
        PG8_WAIT_V(2); PG8_BAR;
        PG8_STAGE(PG8_SB(1, 0), cB + kstep, voffB); PG8_STAGE(PG8_SA(1, 0), cA + kstepA, voffA); PG8_STAGE(PG8_SB(1, 1), cB + hstep + kstep, voffB);
        PG8_WAIT_V(6); PG8_BAR;
    } else {
        PG8_STAGE(PG8_SB(0, 0), cB, voffB); PG8_STAGE(PG8_SA(0, 0), cA, voffA); PG8_STAGE(PG8_SB(0, 1), cB + hstep, voffB); PG8_STAGE(PG8_SA(0, 1), cA + hstepA, voffA);
        if (wr == 1) PG8_BAR;
        PG8_WAIT_V(4); PG8_BAR;
        PG8_STAGE(PG8_SB(1, 0), cB + kstep, voffB); PG8_STAGE(PG8_SA(1, 0), cA + kstepA, voffA); PG8_STAGE(PG8_SB(1, 1), cB + hstep + kstep, voffB);
        PG8_WAIT_V(6); PG8_BAR;
    }
    for (;;) {
        const bool has_next = S.next(ui + 1, nxt);
        const char* nA = has_next ? (const char*)((g.A2 && nxt.ph) ? g.A2 : g.A) + (size_t)nxt.pm * tstepA : cA; const char* nB = has_next ? (const char*)((g.A2 && nxt.ph) ? g.Bt2 : g.Bt) + (size_t)nxt.pn * tstep : cB;
        for (int t = 0; t < nt; t += 2) {
            const bool last = (t == nt - 2);
            const char* a1 = cA + (size_t)(t + 1) * kstepA;
            const char* a2 = last ? nA : cA + (size_t)(t + 2) * kstepA; const char* b2 = last ? nB : cB + (size_t)(t + 2) * kstep;
            const char* a3 = a2 + kstepA; const char* b3 = b2 + kstep;
            if (last && has_next) S.a_ready(nxt, ui + 1);
            if constexpr (SP2) {
            PG8_LDB(B0, 0, 0); PG8_LDB(B1, 0, 1); PG8_SCHED; PG8_LDA(At, 0, 0); PG8_STAGE(PG8_SA(1, 1), a1 + hstepA, voffA);
            PG8_WAIT_V(8); PG8_WAIT_L(0); PG8_BAR; PG8_MMA(0, 0, At, B0); PG8_MMA(0, 1, At, B1); PG8_BAR; PG8_SCHED;
            PG8_LDA(At, 0, 1); PG8_STAGE(PG8_SB(0, 0), b2, voffB); PG8_STAGE(PG8_SB(0, 1), b2 + hstep, voffB); PG8_STAGE(PG8_SA(0, 0), a2, voffA);
            PG8_WAIT_V(8); PG8_WAIT_L(0); PG8_BAR; PG8_MMA(1, 0, At, B0); PG8_MMA(1, 1, At, B1); PG8_BAR; PG8_SCHED;
            PG8_LDB(B0, 1, 0); PG8_LDB(B1, 1, 1); PG8_SCHED; PG8_LDA(At, 1, 0); PG8_STAGE(PG8_SA(0, 1), a2 + hstepA, voffA);
            PG8_WAIT_V(8); PG8_WAIT_L(0); PG8_BAR; PG8_MMA(0, 0, At, B0); PG8_MMA(0, 1, At, B1); PG8_BAR; PG8_SCHED;
            PG8_LDA(At, 1, 1); PG8_STAGE(PG8_SB(1, 0), b3, voffB); PG8_STAGE(PG8_SB(1, 1), b3 + hstep, voffB); PG8_STAGE(PG8_SA(1, 0), a3, voffA);
            PG8_WAIT_V(8); PG8_WAIT_L(0); PG8_BAR; PG8_MMA(1, 0, At, B0); PG8_MMA(1, 1, At, B1); PG8_BAR; PG8_SCHED;
            } else {
            PG8_LDB(B0, 0, 0); PG8_SCHED; PG8_LDA(At, 0, 0); PG8_STAGE(PG8_SA(1, 1), a1 + hstepA, voffA);
            PG8_WAIT_L(8); PG8_BAR; PG8_WAIT_L(0); PG8_MMA(0, 0, At, B0); PG8_BAR; PG8_SCHED;
            PG8_LDB(B1, 0, 1); PG8_STAGE(PG8_SB(0, 0), b2, voffB);
            PG8_BAR; PG8_WAIT_L(0); PG8_MMA(0, 1, At, B1); PG8_BAR;
            PG8_LDA(At, 0, 1); PG8_STAGE(PG8_SA(0, 0), a2, voffA);
            PG8_BAR; PG8_WAIT_L(0); PG8_MMA(1, 0, At, B0); PG8_BAR; PG8_SCHED;
            PG8_STAGE(PG8_SB(0, 1), b2 + hstep, voffB);
            PG8_WAIT_V(6); PG8_BAR; PG8_MMA(1, 1, At, B1); PG8_BAR;
            PG8_LDB(B0, 1, 0); PG8_SCHED; PG8_LDA(At, 1, 0); PG8_STAGE(PG8_SA(0, 1), a2 + hstepA, voffA);
            PG8_WAIT_L(8); PG8_BAR; PG8_WAIT_L(0); PG8_MMA(0, 0, At, B0); PG8_BAR; PG8_SCHED;
            PG8_LDB(B1, 1, 1); PG8_STAGE(PG8_SB(1, 0), b3, voffB);
            PG8_BAR; PG8_WAIT_L(0); PG8_MMA(0, 1, At, B1); PG8_BAR;
            PG8_LDA(At, 1, 1); PG8_STAGE(PG8_SA(1, 0), a3, voffA);
            PG8_BAR; PG8_WAIT_L(0); PG8_MMA(1, 0, At, B0); PG8_BAR; PG8_SCHED;
            PG8_STAGE(PG8_SB(1, 1), b3 + hstep, voffB);
            PG8_WAIT_V(6); PG8_BAR; PG8_MMA(1, 1, At, B1); PG8_BAR;
            }
        }
        if constexpr (ALIGN_EPI) { if (wr == 0) PG8_BAR; }
        const bool chain_mid = g.A2 && cur.ph == 0;
        if constexpr (!Epi::AFTER_DRAIN) { if (chain_mid) E.mid(acc, cur, wr, wc); else E(acc, cur, wr, wc, fr, fq, ui); S.done(cur); }
        if (!has_next) break;
        if (!chain_mid) {
#pragma unroll
        for (int a = 0; a < 2; ++a)
#pragma unroll
            for (int b = 0; b < 2; ++b)
#pragma unroll
                for (int m = 0; m < 4; ++m)
#pragma unroll
                    for (int n = 0; n < 2; ++n) acc[a][b][m][n] = (f32x4){0.f, 0.f, 0.f, 0.f};
        }
        cur = nxt; cA = nA; cB = nB; ++ui;
        if constexpr (ALIGN_EPI) { if (wr == 1) PG8_BAR; }
    }
    PG8_WAIT_V(0);
    if constexpr (!ALIGN_EPI) { if (wr == 0) PG8_BAR; }
    PG8_BAR;
    if constexpr (Epi::AFTER_DRAIN) { E.fused(acc, cur, wr, wc, fr, fq, lds, wid, lane); S.done(cur); }
#undef PG8_SA
#undef PG8_SB
#undef PG8_STAGE
#undef PG8_LDA
#undef PG8_LDB
#undef PG8_MMA
#undef PG8_WAIT_V
#undef PG8_WAIT_L
#undef PG8_BAR
#undef PG8_SCHED
}
}
#ifndef PROBE_SC_MODE
#define PROBE_SC_MODE 0
#endif
#ifndef PROBE_SC_STAGE
#define PROBE_SC_STAGE 1
#endif
#ifndef PROBE_SC_MMA
#define PROBE_SC_MMA 0
#endif
#ifndef ATT_USE_SCHED
#define ATT_USE_SCHED 0
#endif

typedef unsigned short bf16;
typedef short bf16x8 __attribute__((ext_vector_type(8)));
typedef float f32x4 __attribute__((ext_vector_type(4)));
typedef float f32x2 __attribute__((ext_vector_type(2)));
typedef float f32x16 __attribute__((ext_vector_type(16)));
typedef unsigned u32x4 __attribute__((ext_vector_type(4)));
typedef unsigned u32x2 __attribute__((ext_vector_type(2)));
#define LAS __attribute__((address_space(3)))

constexpr int NTOK = 32768, SEQ = 8192, NBATCH = 4, DM = 1024, DEPTH = 4, DFF = 4096;
constexpr int NG = 32, NP = 16, NS = 64;
constexpr int LCH = 64, NCH = SEQ / LCH, NCOL = NBATCH * NCH;
constexpr int NH = 8, QKD = 96, VD = 64;
constexpr float EPS = 1e-6f;
constexpr int NTHREADS = 512, NWAVES = 8;

constexpr size_t MiB = (size_t)1 << 20;
constexpr size_t WS_PXM = 0;
constexpr size_t WS_ROPE = 2 * MiB;
constexpr size_t WS_PTAB = 3 * MiB;
constexpr size_t WS_BAR = 11 * MiB + 512 * 1024;
constexpr size_t WS_BBAR = 12 * MiB;
constexpr size_t WS_W = 14 * MiB, W_STRIDE = 29425664;
constexpr size_t WO_INS = 0;
constexpr size_t WO_G = WO_INS + (size_t)1280 * 1024 * 2;
constexpr size_t WO_Q = WO_G + (size_t)2048 * 1024 * 2;
constexpr size_t WO_KN = WO_Q + (size_t)768 * 384 * 2;
constexpr size_t WO_V = WO_KN + (size_t)512 * 256 * 2;
constexpr size_t WO_GLU = WO_V + (size_t)512 * 256 * 2;
constexpr size_t WO_OS = WO_GLU + (size_t)512 * 512 * 2;
constexpr size_t WO_OM = WO_OS + (size_t)1024 * 512 * 2;
constexpr size_t WO_O = WO_OM + (size_t)1024 * 512 * 2;
constexpr size_t WO_1 = WO_O + (size_t)1024 * 1024 * 2;
constexpr size_t WO_2 = WO_1 + (size_t)4096 * 1024 * 2;
static_assert(WO_2 + (size_t)4096 * 1024 * 2 <= W_STRIDE, "weights per layer");
constexpr size_t WS_PXF = WS_W + DEPTH * W_STRIDE;
constexpr size_t WS_PCQ = WS_PXF + 2 * MiB;
constexpr size_t WS_PCKV = WS_PCQ + 1 * MiB;
static_assert(WS_PCKV + MiB / 2 <= 130 * MiB, "partials");
constexpr size_t WS_XB = 130 * MiB;
constexpr size_t WS_KT = WS_XB + 64 * MiB;
constexpr size_t WS_WA = WS_KT + 2 * MiB;
constexpr size_t WS_WC = WS_WA + 16 * MiB;
constexpr size_t WS_SMALL = WS_WC + 16 * MiB;
constexpr int SM_CRE = 0, SM_CIM = 131072, SM_BG = 262144, SM_BGLU = 270336, SM_DD = 272384, SM_QG = 274432, SM_KG = 274816, SM_END = 275200;
constexpr size_t WS_AR = WS_WC + 16 * MiB + 2 * MiB;
constexpr size_t AR_U = WS_AR, AR_CQ = WS_AR + 32 * MiB, AR_CKV = WS_AR + 56 * MiB, AR_KR = WS_AR + 72 * MiB, AR_Q = WS_AR + 74 * MiB, AR_KN = WS_AR + 122 * MiB,
                 AR_VT = WS_AR + 154 * MiB, AR_K = WS_AR + 186 * MiB, AR_S = WS_AR + 234 * MiB, AR_H = WS_AR + 250 * MiB;
constexpr size_t AR_O = WS_AR + 32 * MiB, AR_YG = WS_AR + 122 * MiB, AR_GATES = WS_AR + 154 * MiB, AR_YSSM = WS_AR, AR_MRG = WS_AR + 64 * MiB, AR_HID = WS_AR;
constexpr size_t WS_END = WS_AR + 282 * MiB;
static_assert(WS_END == 512 * MiB, "ws map");

__device__ __forceinline__ unsigned f2bf(float f) { unsigned u = __builtin_bit_cast(unsigned, f); return (u + 0x7fffu + ((u >> 16) & 1u)) >> 16; }
__device__ __forceinline__ unsigned pk2(float lo, float hi) { return pg8::cvt_pk_bf16(lo, hi); }
__device__ __forceinline__ float bflo(unsigned w) { return __builtin_bit_cast(float, w << 16); }
__device__ __forceinline__ float bfhi(unsigned w) { return __builtin_bit_cast(float, w & 0xffff0000u); }
__device__ __forceinline__ u32x4 pack8(f32x4 a, f32x4 b) { u32x4 w; w.x = pk2(a[0], a[1]); w.y = pk2(a[2], a[3]); w.z = pk2(b[0], b[1]); w.w = pk2(b[2], b[3]); return w; }
__device__ __forceinline__ void unpack8(u32x4 w, f32x4& a, f32x4& b) { a = (f32x4){bflo(w.x), bfhi(w.x), bflo(w.y), bfhi(w.y)}; b = (f32x4){bflo(w.z), bfhi(w.z), bflo(w.w), bfhi(w.w)}; }
__device__ __forceinline__ int lane_id_asm() { int l; asm volatile("v_mbcnt_lo_u32_b32 %0, -1, 0\n\tv_mbcnt_hi_u32_b32 %0, -1, %0" : "=v"(l)); return l; }
__device__ __forceinline__ int opaque_tid(int wv) { asm volatile("" : "+s"(wv)); return wv * 64 + lane_id_asm(); }
__device__ __forceinline__ float sigmoidf_(float x) { return __builtin_amdgcn_rcpf(1.f + __expf(-x)); }
__device__ __forceinline__ float gelu_tanh(float x) { const float z = 0.7978845608028654f * (x + 0.044715f * x * x * x); const float t = 1.f - 2.f * __builtin_amdgcn_rcpf(__expf(2.f * z) + 1.f); return 0.5f * x * (1.f + t); }
__device__ __forceinline__ float wave_sum(float v) {
#pragma unroll
    for (int o = 1; o < 64; o <<= 1) v += __shfl_xor(v, o);
    return v;
}
__device__ __forceinline__ float sumsq8(f32x4 a, f32x4 b) { return (a[0] * a[0] + a[1] * a[1]) + (a[2] * a[2] + a[3] * a[3]) + (b[0] * b[0] + b[1] * b[1]) + (b[2] * b[2] + b[3] * b[3]); }
__device__ __forceinline__ void row_part_store(float s, float* dst) {
    s += __shfl_xor(s, 16); s += __shfl_xor(s, 32);
    if ((lane_id_asm() >> 4) == 0) *dst = s;
}
__device__ __forceinline__ float hsum4(f32x4 v) { return (v[0] + v[1]) + (v[2] + v[3]); }
__device__ __forceinline__ float sum16(const float* p) { const f32x4* q = (const f32x4*)p; return hsum4((q[0] + q[1]) + (q[2] + q[3])); }
__device__ __forceinline__ float sum8(const float* p) { const f32x4* q = (const f32x4*)p; return hsum4(q[0] + q[1]); }
__device__ __forceinline__ float sum4(const float* p) { return hsum4(*(const f32x4*)p); }

constexpr int LDS_TAB = 131072 + 64;
struct NoPre {};
struct PreRs { float rs; };
template <class T> struct IsChainF { static constexpr bool v = false; };
struct Pre4 { f32x4 v[4]; };
struct PreU2 { u32x4 a, b; };
struct PreU4 { u32x4 a, b, c, d; };
template <class F> struct HookSched {
    pg8::StaticOrder so; F f; LAS unsigned char* lds; int wv; bool chain;
    __device__ __forceinline__ bool next(int i, pg8::Unit& u) const { const bool ok = so.next(chain ? (i >> 1) : i, u); u.ph = chain ? (i & 1) : 0; return ok; }
    __device__ __forceinline__ void a_ready(const pg8::Unit& u, int ui) const {
        if (F::USE_TAB) { const int t = wv * 64 + lane_id_asm(); ((LAS float*)(lds + LDS_TAB))[(ui & 1) * 512 + t] = f.table_val(u.pm, u.pn, t); } }
    __device__ __forceinline__ void done(const pg8::Unit&) const {}
};
template <class F> struct EpiRow8 {
    static constexpr bool PERM = true, AFTER_DRAIN = false; F f; LAS unsigned char* lds;
    __device__ __forceinline__ void mid(pg8::f32x4 (&acc)[2][2][4][2], const pg8::Unit& u, int wr, int wc) const {
        if constexpr (IsChainF<F>::v) {
            const int ln_ = lane_id_asm(), fr = ln_ & 15, fq = ln_ >> 4;
            int col = u.pn * 256 + wc * 32 + 8 * fq; asm volatile("" : "+v"(col));
#pragma unroll
            for (int g = 0; g < 8; g += 2) {
                PreU4 rp[2];
#pragma unroll
                for (int j = 0; j < 2; ++j) { const int ai = (g + j) >> 2, mm = (g + j) & 3; int row = u.pm * 256 + ai * 128 + wr * 64 + mm * 16 + fr; asm volatile("" : "+v"(row)); rp[j] = f.mid_pre(row, col); }
#pragma unroll
                for (int j = 0; j < 2; ++j) { const int ai = (g + j) >> 2, mm = (g + j) & 3; f.mid_apply(rp[j], acc[ai][0][mm][0], acc[ai][0][mm][1], acc[ai][1][mm][0], acc[ai][1][mm][1]); }
                asm volatile("" ::: "memory");
            }
        }
    }
    __device__ __forceinline__ void operator()(const pg8::f32x4 (&acc)[2][2][4][2], const pg8::Unit& u, int wr, int wc, int, int, int ui) const {
        const int ln_ = lane_id_asm(), fr = ln_ & 15, fq = ln_ >> 4;
        int col = u.pn * 256 + wc * 32 + 8 * fq; asm volatile("" : "+v"(col));
        const LAS float* tab = (const LAS float*)(lds + LDS_TAB) + (ui & 1) * 512;
        Pre4 cv = f.pre_col(col);
        if (F::USE_TAB) { const LAS float* tc = tab + 256 + wc * 32 + 8 * fq; cv.v[0] = *(const LAS f32x4*)tc; cv.v[1] = *(const LAS f32x4*)(tc + 4); cv.v[2] = *(const LAS f32x4*)(tc + 128); cv.v[3] = *(const LAS f32x4*)(tc + 132); }
        constexpr int NB = F::BATCH;
#pragma unroll
        for (int g = 0; g < 8; g += NB) {
            typename F::RowPre rp[NB]; int rows[NB]; float rv[NB];
#pragma unroll
            for (int j = 0; j < NB; ++j) { const int ai = (g + j) >> 2, mm = (g + j) & 3; const int rl = ai * 128 + wr * 64 + mm * 16 + fr; int row = u.pm * 256 + rl; asm volatile("" : "+v"(row)); rows[j] = row;
                rv[j] = F::USE_TAB ? tab[rl] : 0.f; rp[j] = f.pre_row(row, col); }
#pragma unroll
            for (int j = 0; j < NB; ++j) { const int ai = (g + j) >> 2, mm = (g + j) & 3; f.apply(rows[j], col, rv[j], cv, rp[j], acc[ai][0][mm][0], acc[ai][0][mm][1], acc[ai][1][mm][0], acc[ai][1][mm][1]); }
            asm volatile("" ::: "memory");
        }
    }
};
struct FInSmall { typedef NoPre RowPre; static constexpr int BATCH = 2; static constexpr bool USE_TAB = true;
    const float* px; float* pcq; float* pckv; bf16 *u, *ckv, *cq, *kr;
    __device__ __forceinline__ float table_val(int pm, int, int t) const { return t < 256 ? rsqrtf(sum16(px + (size_t)(pm * 256 + t) * 16) * (1.f / 1024.f) + EPS) : 0.f; }
    __device__ __forceinline__ Pre4 pre_col(int) const { return Pre4{}; }
    __device__ __forceinline__ RowPre pre_row(int, int) const { return NoPre{}; }
    __device__ __forceinline__ void apply(int row, int col, float rs, const Pre4&, const RowPre&, f32x4 a0, f32x4 b0, f32x4 a1, f32x4 b1) const {
        a0 = a0 * rs; b0 = b0 * rs; a1 = a1 * rs; b1 = b1 * rs;
        const int pn = col >> 8, wc = (col >> 5) & 3;
        if (pn < 2) { *(u32x4*)(u + (size_t)row * 512 + col) = pack8(a0, b0); *(u32x4*)(u + (size_t)row * 512 + col + 128) = pack8(a1, b1); }
        else if (pn == 2) { bf16* d = ckv + (size_t)row * 256 + (col - 512); *(u32x4*)d = pack8(a0, b0); *(u32x4*)(d + 128) = pack8(a1, b1);
            row_part_store(sumsq8(a0, b0) + sumsq8(a1, b1), pckv + (size_t)row * 4 + wc); }
        else if (pn == 3) { bf16* d = cq + (size_t)row * 384 + (col - 768); *(u32x4*)d = pack8(a0, b0); *(u32x4*)(d + 128) = pack8(a1, b1);
            row_part_store(sumsq8(a0, b0) + sumsq8(a1, b1), pcq + (size_t)row * 8 + wc); }
        else { *(u32x4*)(cq + (size_t)row * 384 + (col - 768)) = pack8(a0, b0);
            row_part_store(sumsq8(a0, b0), pcq + (size_t)row * 8 + 4 + wc);
            if (wc == 0) *(u32x4*)(kr + (size_t)row * 32 + (col - 1024)) = pack8(a1, b1); }
    } };
template <int NSLOT> struct FScaled { typedef PreRs RowPre; static constexpr int BATCH = 4; static constexpr bool USE_TAB = false;
    bf16* O; int ldc; const float* part; float inv_k;
    __device__ __forceinline__ float table_val(int, int, int) const { return 0.f; }
    __device__ __forceinline__ Pre4 pre_col(int) const { return Pre4{}; }
    __device__ __forceinline__ RowPre pre_row(int row, int) const { const float ss = NSLOT == 8 ? sum8(part + (size_t)row * 8) : sum4(part + (size_t)row * 4); return PreRs{rsqrtf(ss * inv_k + EPS)}; }
    __device__ __forceinline__ void apply(int row, int col, float, const Pre4&, const RowPre& rp, f32x4 a0, f32x4 b0, f32x4 a1, f32x4 b1) const {
        const float rs = rp.rs; bf16* d = O + (size_t)row * ldc + col; *(u32x4*)d = pack8(a0 * rs, b0 * rs); *(u32x4*)(d + 128) = pack8(a1 * rs, b1 * rs);
    } };
struct FVt { typedef NoPre RowPre; static constexpr int BATCH = 4; static constexpr bool USE_TAB = false;
    bf16* Vt; const float* pckv;
    __device__ __forceinline__ float table_val(int, int, int) const { return 0.f; }
    __device__ __forceinline__ Pre4 pre_col(int col) const { Pre4 p;
#pragma unroll
        for (int i = 0; i < 4; ++i) { p.v[0][i] = rsqrtf(sum4(pckv + (size_t)(col + i) * 4) * (1.f / 256.f) + EPS); p.v[1][i] = rsqrtf(sum4(pckv + (size_t)(col + 4 + i) * 4) * (1.f / 256.f) + EPS);
            p.v[2][i] = rsqrtf(sum4(pckv + (size_t)(col + 128 + i) * 4) * (1.f / 256.f) + EPS); p.v[3][i] = rsqrtf(sum4(pckv + (size_t)(col + 132 + i) * 4) * (1.f / 256.f) + EPS); }
        return p; }
    __device__ __forceinline__ RowPre pre_row(int, int) const { return NoPre{}; }
    __device__ __forceinline__ void apply(int row, int col, float, const Pre4& cp, const RowPre&, f32x4 a0, f32x4 b0, f32x4 a1, f32x4 b1) const {
        const int bb = col >> 13, s = col & 8191;
        bf16* d = Vt + ((size_t)(bb * 512 + row) * 8192 + s);
        *(u32x4*)d = pack8(a0 * cp.v[0], b0 * cp.v[1]); *(u32x4*)(d + 128) = pack8(a1 * cp.v[2], b1 * cp.v[3]);
    } };
struct FGates { typedef NoPre RowPre; static constexpr int BATCH = 2; static constexpr bool USE_TAB = true;
    bf16* G; const float* px; const float* bias;
    __device__ __forceinline__ float table_val(int pm, int pn, int t) const { return t < 256 ? rsqrtf(sum16(px + (size_t)(pm * 256 + t) * 16) * (1.f / 1024.f) + EPS) : bias[pn * 256 + t - 256]; }
    __device__ __forceinline__ Pre4 pre_col(int) const { return Pre4{}; }
    __device__ __forceinline__ RowPre pre_row(int, int) const { return NoPre{}; }
    __device__ __forceinline__ void apply(int row, int col, float rs, const Pre4& cp, const RowPre&, f32x4 a0, f32x4 b0, f32x4 a1, f32x4 b1) const {
#pragma unroll
        for (int i = 0; i < 4; ++i) { a0[i] = sigmoidf_(a0[i] * rs + cp.v[0][i]); b0[i] = sigmoidf_(b0[i] * rs + cp.v[1][i]); a1[i] = sigmoidf_(a1[i] * rs + cp.v[2][i]); b1[i] = sigmoidf_(b1[i] * rs + cp.v[3][i]); }
        bf16* d = G + (size_t)row * 2048 + col; *(u32x4*)d = pack8(a0, b0); *(u32x4*)(d + 128) = pack8(a1, b1);
    } };
struct FGlu { typedef PreU2 RowPre; static constexpr int BATCH = 4; static constexpr bool USE_TAB = false;
    bf16* Y; const bf16* yg; const float* bias;
    __device__ __forceinline__ float table_val(int, int, int) const { return 0.f; }
    __device__ __forceinline__ Pre4 pre_col(int col) const { Pre4 p; p.v[0] = *(const f32x4*)(bias + col); p.v[1] = *(const f32x4*)(bias + col + 4); p.v[2] = *(const f32x4*)(bias + col + 128); p.v[3] = *(const f32x4*)(bias + col + 132); return p; }
    __device__ __forceinline__ RowPre pre_row(int row, int col) const { const bf16* s = yg + ((size_t)(col >> 4) * NTOK + row) * 16 + (col & 15); return PreU2{*(const u32x4*)s, *(const u32x4*)(s + (size_t)8 * NTOK * 16)}; }
    __device__ __forceinline__ void apply(int row, int col, float, const Pre4& cp, const RowPre& rp, f32x4 a0, f32x4 b0, f32x4 a1, f32x4 b1) const {
        f32x4 y0, y1, y2, y3; unpack8(rp.a, y0, y1); unpack8(rp.b, y2, y3);
#pragma unroll
        for (int i = 0; i < 4; ++i) { a0[i] = y0[i] * sigmoidf_(a0[i] + cp.v[0][i]); b0[i] = y1[i] * sigmoidf_(b0[i] + cp.v[1][i]); a1[i] = y2[i] * sigmoidf_(a1[i] + cp.v[2][i]); b1[i] = y3[i] * sigmoidf_(b1[i] + cp.v[3][i]); }
        bf16* d = Y + (size_t)row * 512 + col; *(u32x4*)d = pack8(a0, b0); *(u32x4*)(d + 128) = pack8(a1, b1);
    } };
template <bool SECOND> struct FOut { typedef PreU4 RowPre; static constexpr int BATCH = SECOND ? 2 : 4; static constexpr bool USE_TAB = false;
    bf16* M; const bf16* G;
    __device__ __forceinline__ float table_val(int, int, int) const { return 0.f; }
    __device__ __forceinline__ Pre4 pre_col(int) const { return Pre4{}; }
    __device__ __forceinline__ RowPre pre_row(int row, int col) const { PreU4 p; const bf16* g = G + (size_t)row * 2048 + (SECOND ? 1024 : 0) + col; p.a = *(const u32x4*)g; p.b = *(const u32x4*)(g + 128);
        if (SECOND) { const bf16* mm = M + (size_t)row * 1024 + col; p.c = *(const u32x4*)mm; p.d = *(const u32x4*)(mm + 128); } else { p.c = p.a; p.d = p.b; } return p; }
    __device__ __forceinline__ void apply(int row, int col, float, const Pre4&, const RowPre& rp, f32x4 a0, f32x4 b0, f32x4 a1, f32x4 b1) const {
        f32x4 g0, g1, g2, g3; unpack8(rp.a, g0, g1); unpack8(rp.b, g2, g3);
        a0 = a0 * g0; b0 = b0 * g1; a1 = a1 * g2; b1 = b1 * g3;
        if (SECOND) { f32x4 m0, m1, m2, m3; unpack8(rp.c, m0, m1); unpack8(rp.d, m2, m3); a0 = a0 + m0; b0 = b0 + m1; a1 = a1 + m2; b1 = b1 + m3; }
        bf16* d = M + (size_t)row * 1024 + col; *(u32x4*)d = pack8(a0, b0); *(u32x4*)(d + 128) = pack8(a1, b1);
    } };
struct FOutChain { typedef PreU2 RowPre; static constexpr int BATCH = 4; static constexpr bool USE_TAB = false;
    bf16* M; const bf16* G;
    __device__ __forceinline__ float table_val(int, int, int) const { return 0.f; }
    __device__ __forceinline__ Pre4 pre_col(int) const { return Pre4{}; }
    __device__ __forceinline__ PreU4 mid_pre(int row, int col) const { const bf16* g = G + (size_t)row * 2048 + col; PreU4 p; p.a = *(const u32x4*)g; p.b = *(const u32x4*)(g + 128); p.c = *(const u32x4*)(g + 1024); p.d = *(const u32x4*)(g + 1024 + 128); return p; }
    __device__ __forceinline__ void mid_apply(const PreU4& rp, f32x4& a0, f32x4& b0, f32x4& a1, f32x4& b1) const {
        f32x4 g0, g1, g2, g3, h0, h1, h2, h3; unpack8(rp.a, g0, g1); unpack8(rp.b, g2, g3); unpack8(rp.c, h0, h1); unpack8(rp.d, h2, h3);
#pragma unroll
        for (int i = 0; i < 4; ++i) { a0[i] *= g0[i] * __builtin_amdgcn_rcpf(h0[i]); b0[i] *= g1[i] * __builtin_amdgcn_rcpf(h1[i]); a1[i] *= g2[i] * __builtin_amdgcn_rcpf(h2[i]); b1[i] *= g3[i] * __builtin_amdgcn_rcpf(h3[i]); }
    }
    __device__ __forceinline__ RowPre pre_row(int row, int col) const { const bf16* g = G + (size_t)row * 2048 + 1024 + col; return PreU2{*(const u32x4*)g, *(const u32x4*)(g + 128)}; }
    __device__ __forceinline__ void apply(int row, int col, float, const Pre4&, const RowPre& rp, f32x4 a0, f32x4 b0, f32x4 a1, f32x4 b1) const {
        f32x4 h0, h1, h2, h3; unpack8(rp.a, h0, h1); unpack8(rp.b, h2, h3);
        bf16* d = M + (size_t)row * 1024 + col; *(u32x4*)d = pack8(a0 * h0, b0 * h1); *(u32x4*)(d + 128) = pack8(a1 * h2, b1 * h3);
    } };
template <> struct IsChainF<FOutChain> { static constexpr bool v = true; };
struct FResid { typedef Pre4 RowPre; static constexpr int BATCH = 4; static constexpr bool USE_TAB = false;
    const float* xold; float* out; bf16* xb; float* part_next;
    __device__ __forceinline__ float table_val(int, int, int) const { return 0.f; }
    __device__ __forceinline__ Pre4 pre_col(int) const { return Pre4{}; }
    __device__ __forceinline__ RowPre pre_row(int row, int col) const { const float* s = xold + (size_t)row * 1024 + col; Pre4 p; p.v[0] = *(const f32x4*)s; p.v[1] = *(const f32x4*)(s + 4); p.v[2] = *(const f32x4*)(s + 128); p.v[3] = *(const f32x4*)(s + 132); return p; }
    __device__ __forceinline__ void apply(int row, int col, float, const Pre4&, const RowPre& rp, f32x4 a0, f32x4 b0, f32x4 a1, f32x4 b1) const {
        const size_t o = (size_t)row * 1024 + col;
        a0 = a0 + rp.v[0]; b0 = b0 + rp.v[1]; a1 = a1 + rp.v[2]; b1 = b1 + rp.v[3];
        *(f32x4*)(out + o) = a0; *(f32x4*)(out + o + 4) = b0; *(f32x4*)(out + o + 128) = a1; *(f32x4*)(out + o + 132) = b1;
        *(u32x4*)(xb + o) = pack8(a0, b0); *(u32x4*)(xb + o + 128) = pack8(a1, b1);
        if (part_next) row_part_store(sumsq8(a0, b0) + sumsq8(a1, b1), part_next + (size_t)row * 16 + (col >> 8) * 4 + ((col >> 5) & 3));
    } };
struct FFf1 { typedef NoPre RowPre; static constexpr int BATCH = 2; static constexpr bool USE_TAB = true;
    bf16* Hd; const float* px;
    __device__ __forceinline__ float table_val(int pm, int, int t) const { return t < 256 ? rsqrtf(sum16(px + (size_t)(pm * 256 + t) * 16) * (1.f / 1024.f) + EPS) : 0.f; }
    __device__ __forceinline__ Pre4 pre_col(int) const { return Pre4{}; }
    __device__ __forceinline__ RowPre pre_row(int, int) const { return NoPre{}; }
    __device__ __forceinline__ void apply(int row, int col, float rs, const Pre4&, const RowPre&, f32x4 a0, f32x4 b0, f32x4 a1, f32x4 b1) const {
#pragma unroll
        for (int i = 0; i < 4; ++i) { float t = fmaxf(a0[i] * rs, 0.f); a0[i] = t * t; t = fmaxf(b0[i] * rs, 0.f); b0[i] = t * t; t = fmaxf(a1[i] * rs, 0.f); a1[i] = t * t; t = fmaxf(b1[i] * rs, 0.f); b1[i] = t * t; }
        bf16* d = Hd + (size_t)row * 4096 + col; *(u32x4*)d = pack8(a0, b0); *(u32x4*)(d + 128) = pack8(a1, b1);
    } };

struct FNull { typedef NoPre RowPre; static constexpr int BATCH = 8; static constexpr bool USE_TAB = false;
    __device__ __forceinline__ float table_val(int, int, int) const { return 0.f; }
    __device__ __forceinline__ Pre4 pre_col(int) const { return Pre4{}; }
    __device__ __forceinline__ RowPre pre_row(int, int) const { return NoPre{}; }
    __device__ __forceinline__ void apply(int, int, float, const Pre4&, const RowPre&, f32x4 a0, f32x4 b0, f32x4 a1, f32x4 b1) const { asm volatile("" :: "v"(a0), "v"(b0), "v"(a1), "v"(b1)); } };
template <class F> __device__ __forceinline__ void run_gemm(LAS unsigned char* lds, int wv, const bf16* A, const bf16* Bt, int M, int N, int K, const F& f, int a_gm = 0) {
    pg8::Gemm g{A, Bt, M, N, K, a_gm, nullptr, nullptr};
    pg8::StaticOrder so; so.init(M, N, (int)gridDim.x, (int)blockIdx.x);
    HookSched<F> S{so, f, lds, wv, false};
    EpiRow8<F> E{f, lds};
    pg8::gemm_phase<EpiRow8<F>, HookSched<F>, true, true>(lds, g, S, E, opaque_tid(wv));
    __syncthreads();
}

template <class F> __device__ __forceinline__ void run_gemm_chain(LAS unsigned char* lds, int wv, const bf16* A, const bf16* Bt, const bf16* A2, const bf16* Bt2, int M, int N, int K, const F& f) {
    pg8::Gemm g{A, Bt, M, N, K, 0, A2, Bt2};
    pg8::StaticOrder so; so.init(M, N, (int)gridDim.x, (int)blockIdx.x);
    HookSched<F> S{so, f, lds, wv, true};
    EpiRow8<F> E{f, lds};
    pg8::gemm_phase<EpiRow8<F>, HookSched<F>, true, true>(lds, g, S, E, opaque_tid(wv));
    __syncthreads();
}

struct TrJob { const float* src; const float* gain; bf16* dst; int ldw, dstK; };
__device__ __forceinline__ void tr_load(const TrJob& j, int lane, f32x4 (&v)[8]) {
#pragma unroll
    for (int i = 0; i < 8; ++i) { const int kk = 8 * i + (lane >> 3), nn = 4 * (lane & 7); v[i] = *(const f32x4*)(j.src + (size_t)kk * j.ldw + nn); if (j.gain) v[i] = v[i] * j.gain[kk]; }
}
__device__ __forceinline__ void tr_finish(const TrJob& j, int lane, const f32x4 (&v)[8], LAS float* scr) {
#pragma unroll
    for (int i = 0; i < 8; ++i) { const int kk = 8 * i + (lane >> 3), nn = 4 * (lane & 7); scr[kk * 33 + nn] = v[i][0]; scr[kk * 33 + nn + 1] = v[i][1]; scr[kk * 33 + nn + 2] = v[i][2]; scr[kk * 33 + nn + 3] = v[i][3]; }
    asm volatile("s_waitcnt lgkmcnt(0)" ::: "memory");
    const int c = lane & 7;
#pragma unroll
    for (int jj = 0; jj < 4; ++jj) { const int n = (lane >> 3) + 8 * jj; const LAS float* s = scr + (8 * c) * 33 + n;
        u32x4 o; o.x = pk2(s[0 * 33], s[1 * 33]); o.y = pk2(s[2 * 33], s[3 * 33]); o.z = pk2(s[4 * 33], s[5 * 33]); o.w = pk2(s[6 * 33], s[7 * 33]);
        *(u32x4*)(j.dst + (size_t)n * j.dstK + 8 * c) = o; }
    asm volatile("s_waitcnt lgkmcnt(0)" ::: "memory");
}

struct Params { const float* in[26]; float* out; unsigned char* ws; int ph_lo, ph_hi; };

constexpr int TI_IN = 16 * 101, TI_Q = 6 * 24, TI_KV = 4 * 32, TI_GLU = 8 * 16, TI_OS = 8 * 32, TI_OM = 8 * 32, TI_O = 16 * 32, TI_1 = 16 * 128, TI_2 = 64 * 32;
constexpr int TI_L = TI_IN + TI_Q + TI_KV + TI_GLU + TI_OS + TI_OM + TI_O + TI_1 + TI_2;
__device__ __forceinline__ TrJob tr_decode(const Params& P, int it) {
    const int l = it / TI_L; int r = it % TI_L;
    unsigned char* wl = P.ws + WS_W + (size_t)l * W_STRIDE;
    const float* W; const float* gain = nullptr; bf16* dst; int ldw, dstK, k0, n0, drow;
    if (r < TI_IN) { const int kb = r / 101, nb = r % 101; n0 = 32 * nb; k0 = 64 * kb; W = P.in[2] + (size_t)l * 1024 * 3232; ldw = 3232; gain = P.in[1] + l * 1024; dstK = 1024; dst = (bf16*)(wl + WO_INS);
        if (n0 < 512) drow = n0; else if (n0 < 896) drow = 768 + (n0 - 512); else if (n0 < 1152) drow = 512 + (n0 - 896); else if (n0 < 1184) drow = 1152; else { dst = (bf16*)(wl + WO_G); drow = n0 - 1184; } }
    else if ((r -= TI_IN) < TI_Q) { const int kb = r / 24, nb = r % 24; n0 = 32 * nb; k0 = 64 * kb; W = P.in[17] + (size_t)l * 384 * 768; ldw = 768; gain = P.in[15] + l * 384; dst = (bf16*)(wl + WO_Q); dstK = 384; drow = n0; }
    else if ((r -= TI_Q) < TI_KV) { const int kb = r / 32, nb = r % 32; n0 = 32 * nb; k0 = 64 * kb; const int h = n0 >> 7, w = n0 & 127; W = P.in[18] + (size_t)l * 256 * 1024; ldw = 1024; gain = P.in[16] + l * 256;
        dst = (bf16*)(wl + (w < 64 ? WO_KN : WO_V)); dstK = 256; drow = h * 64 + (w & 63); }
    else if ((r -= TI_KV) < TI_GLU) { const int kb = r / 16, nb = r % 16; n0 = 32 * nb; k0 = 64 * kb; W = P.in[12] + (size_t)l * 512 * 512; ldw = 512; dst = (bf16*)(wl + WO_GLU); dstK = 512; drow = n0; }
    else if ((r -= TI_GLU) < TI_OS) { const int kb = r / 32, nb = r % 32; n0 = 32 * nb; k0 = 64 * kb; W = P.in[14] + (size_t)l * 512 * 1024; ldw = 1024; dst = (bf16*)(wl + WO_OS); dstK = 512; drow = n0; }
    else if ((r -= TI_OS) < TI_OM) { const int kb = r / 32, nb = r % 32; n0 = 32 * nb; k0 = 64 * kb; W = P.in[21] + (size_t)l * 512 * 1024; ldw = 1024; dst = (bf16*)(wl + WO_OM); dstK = 512; drow = n0; }
    else if ((r -= TI_OM) < TI_O) { const int kb = r / 32, nb = r % 32; n0 = 32 * nb; k0 = 64 * kb; W = P.in[22] + (size_t)l * 1024 * 1024; ldw = 1024; dst = (bf16*)(wl + WO_O); dstK = 1024; drow = n0; }
    else if ((r -= TI_O) < TI_1) { const int kb = r / 128, nb = r % 128; n0 = 32 * nb; k0 = 64 * kb; W = P.in[24] + (size_t)l * 1024 * 4096; ldw = 4096; gain = P.in[23] + l * 1024; dst = (bf16*)(wl + WO_1); dstK = 1024; drow = n0; }
    else { r -= TI_1; const int kb = r / 32, nb = r % 32; n0 = 32 * nb; k0 = 64 * kb; W = P.in[25] + (size_t)l * 4096 * 1024; ldw = 1024; dst = (bf16*)(wl + WO_2); dstK = 4096; drow = n0; }
    TrJob j; j.src = W + (size_t)k0 * ldw + n0; j.gain = gain ? gain + k0 : nullptr; j.dst = dst + (size_t)drow * dstK + k0; j.ldw = ldw; j.dstK = dstK; return j;
}

__device__ __forceinline__ void prologue(const Params& P, LAS unsigned char* lds, const int tid) {
    const int lane = tid & 63, wave = tid >> 6;
    const int gw = blockIdx.x * NWAVES + wave, NGW = gridDim.x * NWAVES;
    const int gt = blockIdx.x * NTHREADS + tid, NGT = gridDim.x * NTHREADS;
    unsigned char* ws = P.ws;
    LAS float* scr = (LAS float*)(lds + wave * 8704);
    { int it = gw; f32x4 va[8], vb[8]; TrJob ja, jb;
      if (it < DEPTH * TI_L) { ja = tr_decode(P, it); tr_load(ja, lane, va); }
      while (it < DEPTH * TI_L) {
          const int it2 = it + NGW; const bool m2 = it2 < DEPTH * TI_L;
          if (m2) { jb = tr_decode(P, it2); tr_load(jb, lane, vb); }
          tr_finish(ja, lane, va, scr);
          if (!m2) break;
          const int it3 = it2 + NGW; const bool m3 = it3 < DEPTH * TI_L;
          if (m3) { ja = tr_decode(P, it3); tr_load(ja, lane, va); }
          tr_finish(jb, lane, vb, scr);
          if (!m3) break;
          it = it3;
      } }
    for (int i = gt; i < DEPTH * 96 * 128; i += NGT) { const int l = i / (96 * 128), r = i % (96 * 128);
        ((u32x4*)(ws + WS_W + (size_t)l * W_STRIDE + WO_INS + (size_t)1184 * 1024 * 2))[r] = (u32x4){0u, 0u, 0u, 0u}; }
    { const float* x = P.in[0]; bf16* xb = (bf16*)(ws + WS_XB); float* pxm = (float*)(ws + WS_PXM);
      int m = gw;
      for (; m + 3 * NGW < NTOK; m += 4 * NGW) {
          f32x4 v[4][4];
#pragma unroll
          for (int r = 0; r < 4; ++r) { const f32x4* xr = (const f32x4*)(x + (size_t)(m + r * NGW) * DM) + lane;
#pragma unroll
              for (int j = 0; j < 4; ++j) v[r][j] = xr[64 * j]; }
#pragma unroll
          for (int r = 0; r < 4; ++r) { const int mr = m + r * NGW; float s = 0.f; u32x2* o8 = (u32x2*)(xb + (size_t)mr * DM) + lane;
#pragma unroll
              for (int j = 0; j < 4; ++j) { const f32x4 q = v[r][j]; s += (q[0] * q[0] + q[1] * q[1]) + (q[2] * q[2] + q[3] * q[3]); u32x2 w; w.x = pk2(q[0], q[1]); w.y = pk2(q[2], q[3]); o8[64 * j] = w; }
              s = wave_sum(s); if (lane < 16) pxm[(size_t)mr * 16 + lane] = lane == 0 ? s : 0.f; }
      }
      for (; m < NTOK; m += NGW) { const f32x4* xr = (const f32x4*)(x + (size_t)m * DM) + lane; float s = 0.f; u32x2* o8 = (u32x2*)(xb + (size_t)m * DM) + lane;
#pragma unroll
          for (int j = 0; j < 4; ++j) { const f32x4 v = xr[64 * j]; s += (v[0] * v[0] + v[1] * v[1]) + (v[2] * v[2] + v[3] * v[3]); u32x2 w; w.x = pk2(v[0], v[1]); w.y = pk2(v[2], v[3]); o8[64 * j] = w; }
          s = wave_sum(s); if (lane < 16) pxm[(size_t)m * 16 + lane] = lane == 0 ? s : 0.f; } }
    { float* smw = (float*)(ws + WS_SMALL);
      for (int i = gt; i < SM_END; i += NGT) { float v;
          if (i < SM_CIM) v = P.in[9][i]; else if (i < SM_BG) v = P.in[10][i - SM_CIM]; else if (i < SM_BGLU) v = P.in[3][i - SM_BG]; else if (i < SM_DD) v = P.in[13][i - SM_BGLU];
          else if (i < SM_QG) v = P.in[11][i - SM_DD]; else if (i < SM_KG) v = P.in[19][i - SM_QG]; else v = P.in[20][i - SM_KG];
          smw[i] = v; } }
    { f32x2* ptab = (f32x2*)(ws + WS_PTAB);
      for (int i = gt; i < DEPTH * NG * 2 * NS * 65; i += NGT) { const int e = i % 65, idx = i / 65;
          const int n = idx & 63, dir = (idx >> 6) & 1, g = (idx >> 7) & 31, l = idx >> 12;
          const int pi = ((l * 2 + dir) * NG + g) * NS + n;
          const double lr = (double)P.in[4][pi], li = (double)P.in[5][pi], st = exp((double)P.in[6][(l * 2 + dir) * NG + g]);
          const double ang = li * st * (double)e, kq = rint(ang * 0.15915494309189535), rr = (ang - kq * 6.283185307179586) - kq * 2.4492935982947064e-16;
          const float mag = expf((float)(lr * st * (double)e)); float sn, cs; sincosf((float)rr, &sn, &cs);
          ptab[i] = (f32x2){mag * cs, mag * sn}; }
      f32x2* bbar = (f32x2*)(ws + WS_BBAR);
      for (int i = gt; i < DEPTH * NG * 2 * NS * NP; i += NGT) { const int q = i & 15, idx = i >> 4;
          const int n = idx & 63, dir = (idx >> 6) & 1, g = (idx >> 7) & 31, l = idx >> 12;
          const int pi = ((l * 2 + dir) * NG + g) * NS + n;
          const double lr = (double)P.in[4][pi], li = (double)P.in[5][pi], st = exp((double)P.in[6][(l * 2 + dir) * NG + g]);
          const double mag = exp(lr * st), ar = mag * cos(li * st), ai = mag * sin(li * st);
          const double nr = ar - 1.0, ni = ai, den = lr * lr + li * li, fr = (nr * lr + ni * li) / den, fi = (ni * lr - nr * li) / den;
          const double br = (double)P.in[7][(size_t)pi * NP + q], bi = (double)P.in[8][(size_t)pi * NP + q];
          bbar[i] = (f32x2){(float)(fr * br - fi * bi), (float)(fr * bi + fi * br)}; } }
    { f32x2* rope = (f32x2*)(ws + WS_ROPE);
      for (int i = gt; i < SEQ * 16; i += NGT) { const int s = i >> 4, j = i & 15; const float inv = powf(10000.f, -(float)j / 16.f); const float ang = (float)s * inv;
          rope[i] = (f32x2){(float)cos((double)ang), (float)sin((double)ang)}; } }
}

__device__ __forceinline__ void ssm_tables(unsigned char* ws, int l, const int tid) {
    const int gt = blockIdx.x * NTHREADS + tid, NGT = gridDim.x * NTHREADS;
    const f32x2* ptab = (const f32x2*)(ws + WS_PTAB) + (size_t)l * NG * 2 * NS * 65;
    const f32x2* bbar = (const f32x2*)(ws + WS_BBAR) + (size_t)l * NG * 2 * NS * NP;
    const float* cre = (const float*)(ws + WS_SMALL) + SM_CRE + (size_t)l * NG * NP * NS; const float* cim = (const float*)(ws + WS_SMALL) + SM_CIM + (size_t)l * NG * NP * NS;
    bf16* WA = (bf16*)(ws + WS_WA); bf16* WC = (bf16*)(ws + WS_WC); bf16* Kt = (bf16*)(ws + WS_KT);
    for (int it = gt; it < NG * 2 * NS * LCH; it += NGT) { const int i = it & 63, n = (it >> 6) & 63, dir = (it >> 12) & 1, g = it >> 13;
        const int pb = (g * 2 + dir) * NS + n; const f32x2 pw = ptab[(size_t)pb * 65 + (dir ? i : 63 - i)];
        unsigned re[8], im[8];
#pragma unroll
        for (int q = 0; q < 16; q += 2) { const f32x2 b0 = bbar[(size_t)pb * NP + q], b1 = bbar[(size_t)pb * NP + q + 1];
            re[q >> 1] = pk2(pw.x * b0.x - pw.y * b0.y, pw.x * b1.x - pw.y * b1.y); im[q >> 1] = pk2(pw.x * b0.y + pw.y * b0.x, pw.x * b1.y + pw.y * b1.x); }
        bf16* r0 = WA + ((size_t)(g * 256 + dir * 128 + 2 * n) * 1024 + i * 16);
        *(u32x4*)(r0) = (u32x4){re[0], re[1], re[2], re[3]}; *(u32x4*)(r0 + 8) = (u32x4){re[4], re[5], re[6], re[7]};
        *(u32x4*)(r0 + 1024) = (u32x4){im[0], im[1], im[2], im[3]}; *(u32x4*)(r0 + 1024 + 8) = (u32x4){im[4], im[5], im[6], im[7]}; }
#pragma unroll 4
    for (int it = gt; it < NG * LCH * NP * 2 * NS; it += NGT) { const int n = it & 63, dir = (it >> 6) & 1, p = (it >> 7) & 15, i = (it >> 11) & 63, g = it >> 17;
        const f32x2 pw = ptab[(size_t)((g * 2 + dir) * NS + n) * 65 + (dir ? 64 - i : i + 1)];
        const float cr = cre[(g * NP + p) * NS + n], ci = cim[(g * NP + p) * NS + n];
        ((unsigned*)WC)[((size_t)(g * 1024 + i * 16 + p) * 256 + dir * 128 + 2 * n) >> 1] = pk2(cr * pw.x - ci * pw.y, -(cr * pw.y + ci * pw.x)); }
}
__device__ __forceinline__ void ssm_kt_task(unsigned char* ws, LAS unsigned char* lds, int l, int task, int tid) {
    const int g = task >> 3, lb = task & 7;
    const f32x2* ptab = (const f32x2*)(ws + WS_PTAB) + (size_t)l * NG * 2 * NS * 65;
    const f32x2* bbar = (const f32x2*)(ws + WS_BBAR) + (size_t)l * NG * 2 * NS * NP;
    const float* cre = (const float*)(ws + WS_SMALL) + SM_CRE + (size_t)l * NG * NP * NS; const float* cim = (const float*)(ws + WS_SMALL) + SM_CIM + (size_t)l * NG * NP * NS;
    LAS f32x2* Pl = (LAS f32x2*)lds;
#pragma unroll
    for (int r = 0; r < 4; ++r) { const int c = r * 512 + tid, s = c & 15, n = (c >> 4) & 63, dir = c >> 10; const int d = lb * 16 + s - 63;
        const bool ok = dir == 0 ? (d >= 0) : (d <= 0); const int e = d < 0 ? -d : d;
        f32x2 v = (f32x2){0.f, 0.f}; if (ok && e <= 64) v = ptab[(size_t)((g * 2 + dir) * NS + n) * 65 + e];
        Pl[c] = v; }
    __syncthreads();
    const int pq = tid & 255, p = pq >> 4, q = pq & 15, half = tid >> 8;
    float acc[8];
#pragma unroll
    for (int s = 0; s < 8; ++s) acc[s] = 0.f;
    for (int dir = 0; dir < 2; ++dir) {
        const int dlo = lb * 16 + half * 8 - 63, dhi = dlo + 7;
        if (dir == 0 ? (dhi < 0) : (dlo > 0)) continue;
        const float* cr_ = cre + (g * NP + p) * NS; const float* ci_ = cim + (g * NP + p) * NS; const f32x2* bb = bbar + (size_t)((g * 2 + dir) * NS) * NP + q;
#pragma unroll 8
        for (int n = 0; n < NS; ++n) { const float cr = cr_[n], ci = ci_[n]; const f32x2 b = bb[n * NP];
            const float xr = cr * b.x - ci * b.y, xi = cr * b.y + ci * b.x;
#pragma unroll
            for (int s = 0; s < 8; ++s) { const f32x2 pw = Pl[(dir * 64 + n) * 16 + half * 8 + s]; acc[s] += xr * pw.x - xi * pw.y; } }
    }
    bf16* Kt = (bf16*)(ws + WS_KT);
#pragma unroll
    for (int s = 0; s < 8; ++s) { const int dd = lb * 16 + half * 8 + s; if (dd < 127) Kt[((size_t)(g * 127 + dd) * 16 + p) * 16 + q] = (bf16)f2bf(acc[s]); }
    __syncthreads();
}

constexpr int SS_KT = 0, SS_UB = 65536;
__device__ __forceinline__ void ssm_stage_u(unsigned char* ws, LAS unsigned char* lds, int g, int cb, int hh, int tid) {
    asm volatile("" : "+v"(tid));
    const bf16* U = (const bf16*)(ws + AR_U);
    u32x4 v[8];
#pragma unroll
    for (int r = 0; r < 8; ++r) { const int c = r * 512 + tid, jj = c >> 7, col = (c >> 1) & 63, part = c & 1;
        v[r] = *(const u32x4*)(U + ((size_t)((cb * 64 + col) * 64 + hh * 32 + jj) * 512 + g * 16 + part * 8)); }
#pragma unroll
    for (int r = 0; r < 8; ++r) { const int c = r * 512 + tid; *(LAS u32x4*)(lds + SS_UB + c * 16) = v[r]; }
}
__device__ __forceinline__ void ssm_a_task(unsigned char* ws, LAS unsigned char* lds, int task, int tid) {
    const int lane = tid & 63, wid = tid >> 6, rr = lane & 15, kk = lane >> 4;
    const int g = task >> 3, cb = task & 7;
    f32x4 acc[2][4];
#pragma unroll
    for (int a = 0; a < 2; ++a)
#pragma unroll
        for (int c = 0; c < 4; ++c) acc[a][c] = (f32x4){0.f, 0.f, 0.f, 0.f};
    const bf16* WA = (const bf16*)(ws + WS_WA) + ((size_t)(g * 256 + wid * 32 + rr) * 1024 + 8 * kk);
    for (int hh = 0; hh < 2; ++hh) {
        ssm_stage_u(ws, lds, g, cb, hh, tid);
        __syncthreads();
#pragma unroll 4
        for (int ks = 0; ks < 16; ++ks) {
            bf16x8 bfr[4], afr[2];
#pragma unroll
            for (int a = 0; a < 2; ++a) afr[a] = *(const bf16x8*)(WA + (size_t)a * 16 * 1024 + (hh * 16 + ks) * 32);
#pragma unroll
            for (int c = 0; c < 4; ++c) bfr[c] = *(const LAS bf16x8*)(lds + SS_UB + (((2 * ks + (kk >> 1)) * 64 + c * 16 + rr) * 32 + (kk & 1) * 16));
#pragma unroll
            for (int a = 0; a < 2; ++a)
#pragma unroll
                for (int c = 0; c < 4; ++c) acc[a][c] = __builtin_amdgcn_mfma_f32_16x16x32_bf16(afr[a], bfr[c], acc[a][c], 0, 0, 0);
        }
        __syncthreads();
    }
    float* S = (float*)(ws + AR_S);
#pragma unroll
    for (int a = 0; a < 2; ++a)
#pragma unroll
        for (int c = 0; c < 4; ++c) { const int col = cb * 64 + c * 16 + rr; *(f32x4*)(S + ((size_t)(col * NG + g) * 256 + wid * 32 + a * 16 + 4 * kk)) = acc[a][c]; }
}
template <int PMODE> __device__ __forceinline__ void ssm_c_task(unsigned char* ws, LAS unsigned char* lds, int l, int task, int tid_in) {
    const int tid = tid_in; const int lane = tid & 63, wid = tid >> 6, rr = lane & 15, kk = lane >> 4;
    const int g = task >> 3, cb = task & 7;
    const bf16* U = (const bf16*)(ws + AR_U);
    f32x4 acc[8][4];
#pragma unroll
    for (int a = 0; a < 8; ++a)
#pragma unroll
        for (int c = 0; c < 4; ++c) acc[a][c] = (f32x4){0.f, 0.f, 0.f, 0.f};
    { const u32x4* src = (const u32x4*)((const bf16*)(ws + WS_KT) + (size_t)g * 127 * 256);
#pragma unroll
      for (int r = 0; r < 8; ++r) { const int c = r * 512 + tid; if (c < 127 * 32) *(LAS u32x4*)(lds + SS_KT + c * 16) = src[c]; } }
    for (int hh = 0; hh < 2; ++hh) {
        for (int rs_ = 0; rs_ < PROBE_SC_STAGE; ++rs_) { if (rs_) __syncthreads(); ssm_stage_u(ws, lds, g, cb, hh, tid); }
        __syncthreads();
#if PROBE_SC_MMA
        { f32x4 dac[8][4];
#pragma unroll
          for (int a = 0; a < 8; ++a)
#pragma unroll
            for (int c = 0; c < 4; ++c) dac[a][c] = (f32x4){0.f, 0.f, 0.f, 0.f};
#pragma unroll 2
          for (int ks = 0; ks < 16; ++ks) {
            bf16x8 bfr[4];
#pragma unroll
            for (int c = 0; c < 4; ++c) bfr[c] = *(const LAS bf16x8*)(lds + SS_UB + (((2 * ks + (kk >> 1)) * 64 + c * 16 + rr) * 32 + (kk & 1) * 16));
            const int j = hh * 32 + 2 * ks + (kk >> 1);
#pragma unroll
            for (int a = 0; a < 8; ++a) { const int i = wid * 8 + a;
                const bf16x8 af = *(const LAS bf16x8*)(lds + SS_KT + (i - j + 63) * 512 + rr * 32 + (kk & 1) * 16);
#pragma unroll
                for (int c = 0; c < 4; ++c) dac[a][c] = __builtin_amdgcn_mfma_f32_16x16x32_bf16(af, bfr[c], dac[a][c], 0, 0, 0); }
          }
#pragma unroll
          for (int a = 0; a < 8; ++a)
#pragma unroll
            for (int c = 0; c < 4; ++c) asm volatile("" :: "v"(dac[a][c]));
        }
#endif
#pragma unroll 2
        for (int ks = 0; ks < (PMODE == 3 ? 0 : 16); ++ks) {
            bf16x8 bfr[4];
#pragma unroll
            for (int c = 0; c < 4; ++c) bfr[c] = *(const LAS bf16x8*)(lds + SS_UB + (((2 * ks + (kk >> 1)) * 64 + c * 16 + rr) * 32 + (kk & 1) * 16));
            const int j = hh * 32 + 2 * ks + (kk >> 1);
#pragma unroll
            for (int a = 0; a < 8; ++a) { const int i = wid * 8 + a;
                const bf16x8 af = *(const LAS bf16x8*)(lds + SS_KT + (i - j + 63) * 512 + rr * 32 + (kk & 1) * 16);
#pragma unroll
                for (int c = 0; c < 4; ++c) acc[a][c] = __builtin_amdgcn_mfma_f32_16x16x32_bf16(af, bfr[c], acc[a][c], 0, 0, 0); }
        }
        __syncthreads();
    }
    if (PMODE >= 2) {
#pragma unroll
        for (int a = 0; a < 8; ++a)
#pragma unroll
            for (int c = 0; c < 4; ++c) asm volatile("" :: "v"(acc[a][c]));
        __syncthreads(); return; }
    { const bf16* Hb = (const bf16*)(ws + AR_H); int tid = tid_in; asm volatile("" : "+v"(tid));
      u32x4 v[4];
#pragma unroll
      for (int r = 0; r < 4; ++r) { const int c = r * 512 + tid, col = c & 63, kc = c >> 6; v[r] = *(const u32x4*)(Hb + ((size_t)((cb * 64 + col) * NG + g) * 256 + kc * 8)); }
#pragma unroll
      for (int r = 0; r < 4; ++r) { const int c = r * 512 + tid; *(LAS u32x4*)(lds + SS_UB + c * 16) = v[r]; } }
    __syncthreads();
    { const bf16* WC = (const bf16*)(ws + WS_WC) + ((size_t)(g * 1024 + wid * 128 + rr) * 256 + 8 * kk);
#pragma unroll 1
      for (int ks = 0; ks < 8; ++ks) {
          bf16x8 bfr[4], afr[8];
#pragma unroll
          for (int a = 0; a < 8; ++a) afr[a] = *(const bf16x8*)(WC + (size_t)a * 16 * 256 + ks * 32);
#pragma unroll
          for (int c = 0; c < 4; ++c) bfr[c] = *(const LAS bf16x8*)(lds + SS_UB + (((ks * 4 + kk) * 64 + c * 16 + rr) * 16));
#pragma unroll
          for (int a = 0; a < 8; ++a)
#pragma unroll
              for (int c = 0; c < 4; ++c) acc[a][c] = __builtin_amdgcn_mfma_f32_16x16x32_bf16(afr[a], bfr[c], acc[a][c], 0, 0, 0);
      } }
    __syncthreads();
    if (PMODE == 1) {
#pragma unroll
        for (int a = 0; a < 8; ++a)
#pragma unroll
            for (int c = 0; c < 4; ++c) asm volatile("" :: "v"(acc[a][c]));
        return; }
    int rr_e = rr; asm volatile("" : "+v"(rr_e));
    bf16* yb = (bf16*)(ws + AR_YG) + ((size_t)g * NTOK + (size_t)cb * 4096 + (size_t)rr_e * 64 + wid * 8) * 16 + 4 * kk;
    const f32x4 dv = *(const f32x4*)((const float*)(ws + WS_SMALL) + SM_DD + (size_t)l * NG * NP + g * NP + 4 * kk);
#pragma unroll
    for (int a0 = 0; a0 < 8; a0 += 4) {
        u32x2 uw[4][4];
#pragma unroll
        for (int a = 0; a < 4; ++a)
#pragma unroll
            for (int c = 0; c < 4; ++c) { const int col = cb * 64 + c * 16 + rr_e; const size_t tok = (size_t)col * 64 + wid * 8 + a0 + a; uw[a][c] = *(const u32x2*)(U + tok * 512 + g * 16 + 4 * kk); }
#pragma unroll
        for (int a = 0; a < 4; ++a)
#pragma unroll
            for (int c = 0; c < 4; ++c) { const int col = cb * 64 + c * 16 + rr_e; const size_t tok = (size_t)col * 64 + wid * 8 + a0 + a;
                const f32x4 av = acc[a0 + a][c];
                const float y0 = av[0] + dv[0] * bflo(uw[a][c].x), y1 = av[1] + dv[1] * bfhi(uw[a][c].x), y2 = av[2] + dv[2] * bflo(uw[a][c].y), y3 = av[3] + dv[3] * bfhi(uw[a][c].y);
                u32x2 o; o.x = pk2(gelu_tanh(y0), gelu_tanh(y1)); o.y = pk2(gelu_tanh(y2), gelu_tanh(y3));
                if (PMODE == 4) asm volatile("" :: "v"(o)); else *(u32x2*)(yb + (c * 1024 + a0 + a) * 16) = o; }
        asm volatile("" ::: "memory");
    }
}

__device__ __forceinline__ void ssm_scan(unsigned char* ws, int l, int t) {
    const int n = t & 63, dir = (t >> 6) & 1, g = (t >> 7) & 31, b = t >> 12;
    const f32x2 aL = ((const f32x2*)(ws + WS_PTAB))[(size_t)(((l * NG + g) * 2 + dir) * NS + n) * 65 + 64];
    const float* S = (const float*)(ws + AR_S); unsigned* H = (unsigned*)(ws + AR_H);
    float hr = 0.f, hi = 0.f;
    const size_t off = (size_t)g * 256 + dir * 128 + 2 * n;
#pragma unroll 16
    for (int c = 0; c < NCH; ++c) { const int cc = dir ? NCH - 1 - c : c; const size_t col = (size_t)b * NCH + cc;
        const f32x2 s = *(const f32x2*)(S + col * NG * 256 + off);
        H[(col * NG * 256 + off) >> 1] = pk2(hr, hi);
        const float nr = aL.x * hr - aL.y * hi + s.x, ni = aL.x * hi + aL.y * hr + s.y; hr = nr; hi = ni; }
}

__device__ __forceinline__ void prep_item(unsigned char* ws, int l, int item, const int tid) {
    const int lane = tid & 63, j = lane & 3, pr = lane >> 2, h = pr & 7; const size_t tok = (size_t)item * 2 + (pr >> 3);
    const int s = (int)(tok & 8191);
    bf16* Q = (bf16*)(ws + AR_Q); const bf16* KN = (const bf16*)(ws + AR_KN); const bf16* KR = (const bf16*)(ws + AR_KR); bf16* K = (bf16*)(ws + AR_K);
    const f32x2* rope = (const f32x2*)(ws + WS_ROPE) + (size_t)s * 16;
    const float* qg = (const float*)(ws + WS_SMALL) + SM_QG + l * QKD; const float* kg = (const float*)(ws + WS_SMALL) + SM_KG + l * QKD;
    u32x4 wraw[2][3]; f32x2 csv[8];
#pragma unroll
    for (int c = 0; c < 3; ++c) wraw[0][c] = *(const u32x4*)(Q + tok * 768 + h * 96 + (j + 4 * c) * 8);
#pragma unroll
    for (int c = 0; c < 2; ++c) wraw[1][c] = *(const u32x4*)(KN + tok * 512 + h * 64 + (j + 4 * c) * 8);
    wraw[1][2] = *(const u32x4*)(KR + tok * 32 + j * 8);
#pragma unroll
    for (int e = 0; e < 8; ++e) csv[e] = rope[8 * (j & 1) + e];
#pragma unroll
    for (int which = 0; which < 2; ++which) {
        f32x4 v[3][2];
#pragma unroll
        for (int c = 0; c < 3; ++c) unpack8(wraw[which][c], v[c][0], v[c][1]);
        float ss = 0.f;
#pragma unroll
        for (int c = 0; c < 3; ++c) ss += sumsq8(v[c][0], v[c][1]);
        ss += __shfl_xor(ss, 1); ss += __shfl_xor(ss, 2);
        const float rs = rsqrtf(ss * (1.f / 96.f) + EPS);
        const float* gn = which == 0 ? qg : kg;
#pragma unroll
        for (int c = 0; c < 3; ++c) { const f32x4 g0 = *(const f32x4*)(gn + (j + 4 * c) * 8), g1 = *(const f32x4*)(gn + (j + 4 * c) * 8 + 4); v[c][0] = v[c][0] * rs * g0; v[c][1] = v[c][1] * rs * g1; }
        f32x4 o0, o1;
#pragma unroll
        for (int e = 0; e < 4; ++e) { o0[e] = __shfl_xor(v[2][0][e], 2); o1[e] = __shfl_xor(v[2][1][e], 2); }
#pragma unroll
        for (int e = 0; e < 8; ++e) { const f32x2 cs = csv[e]; const float mine = e < 4 ? v[2][0][e] : v[2][1][e - 4], oth = e < 4 ? o0[e] : o1[e - 4];
            const float r = (j < 2) ? (mine * cs.x - oth * cs.y) : (oth * cs.y + mine * cs.x);
            if (e < 4) v[2][0][e] = r; else v[2][1][e - 4] = r; }
        if (which == 0) { const float sc = 0.10206207261596575f * 1.4426950408889634f;
#pragma unroll
            for (int c = 0; c < 3; ++c) { v[c][0] = v[c][0] * sc; v[c][1] = v[c][1] * sc; } }
        bf16* dst = (which == 0 ? Q : K) + tok * 768 + h * 96;
#pragma unroll
        for (int c = 0; c < 3; ++c) *(u32x4*)(dst + (j + 4 * c) * 8) = pack8(v[c][0], v[c][1]);
    }
}

constexpr int AKP = 208, AVP = 144, AKB = 64 * AKP, AVB = 64 * AVP, ABUF = AKB + AVB;
#define ATT_THR 8.0f
__device__ __forceinline__ float max2f(float a, float b) { return __builtin_amdgcn_fmed3f(a, b, __builtin_inff()); }
typedef __bf16 bf16x2_t __attribute__((ext_vector_type(2)));
__device__ __forceinline__ unsigned cvtpk_s(float lo, float hi) { f32x2 v = {lo, hi}; bf16x2_t b = __builtin_convertvector(v, bf16x2_t); return __builtin_bit_cast(unsigned, b); }
template <bool FIXED> __device__ __forceinline__ void attn_unit(unsigned char* ws, LAS unsigned char* lds, int b, int h, int qb, const int tid, const float sbound) {
    const bf16* Q = (const bf16*)(ws + AR_Q); const bf16* K = (const bf16*)(ws + AR_K); const bf16* Vt = (const bf16*)(ws + AR_VT); bf16* O = (bf16*)(ws + AR_O);
    const int lane = tid & 63, wid = tid >> 6, r32 = lane & 31, hi = lane >> 5;
    const size_t tok0 = (size_t)b * SEQ + qb * 256 + wid * 32;
    bf16x8 qf[6];
#pragma unroll
    for (int st = 0; st < 6; ++st) qf[st] = *(const bf16x8*)(Q + (tok0 + r32) * 768 + h * 96 + st * 16 + hi * 8);
    const int kkey0 = tid / 12, kpart0 = tid % 12, kkey1 = (512 + tid) / 12, kpart1 = (512 + tid) % 12, vd = tid >> 3, vpart = tid & 7;
    const bf16* Kg = K + ((size_t)b * SEQ) * 768 + h * 96;
    const bf16* Vg = Vt + ((size_t)(b * NH + h) * 64) * SEQ;
    const bf16* kp0 = Kg + (size_t)kkey0 * 768 + kpart0 * 8; const bf16* kp1 = Kg + (size_t)kkey1 * 768 + kpart1 * 8; const bf16* vp = Vg + (size_t)vd * SEQ + vpart * 8;
    const int kw0 = kkey0 * AKP + kpart0 * 16, kw1 = kkey1 * AKP + kpart1 * 16, vw = AKB + vd * AVP + vpart * 16;
    const bool has1 = tid < 256;
    u32x4 sk0, sk1 = (u32x4){0u, 0u, 0u, 0u}, sv;
#define ATT_LOAD(t) do { sk0 = *(const u32x4*)(kp0 + (size_t)(t) * 64 * 768); if (has1) sk1 = *(const u32x4*)(kp1 + (size_t)(t) * 64 * 768); sv = *(const u32x4*)(vp + (t) * 64); } while (0)
#define ATT_STORE(boff) do { *(LAS u32x4*)(lds + (boff) + kw0) = sk0; if (has1) *(LAS u32x4*)(lds + (boff) + kw1) = sk1; *(LAS u32x4*)(lds + (boff) + vw) = sv; } while (0)
    ATT_LOAD(0); ATT_STORE(0); ATT_LOAD(1); ATT_STORE(ABUF); ATT_LOAD(2);
    __syncthreads();
    const int pi_r = (r32 & ~12) | ((r32 & 4) << 1) | ((r32 & 8) >> 1);
    const int kro = pi_r * AKP + hi * 16, vro = AKB + r32 * AVP + hi * 16;
    f32x16 o0 = {}, o1 = {}, negm = {};
    float mref = 0.f, lsum = 0.f;
#define ATT_QK(P0, P1, boff) do { bf16x8 ka_[6], kb_[6]; \
        _Pragma("unroll") for (int st = 0; st < 6; ++st) { ka_[st] = *(const LAS bf16x8*)(lds + (boff) + kro + st * 32); kb_[st] = *(const LAS bf16x8*)(lds + (boff) + kro + 32 * AKP + st * 32); } \
        P0 = __builtin_amdgcn_mfma_f32_32x32x16_bf16(ka_[0], qf[0], negm, 0, 0, 0); P1 = __builtin_amdgcn_mfma_f32_32x32x16_bf16(kb_[0], qf[0], negm, 0, 0, 0); \
        _Pragma("unroll") for (int st = 1; st < 6; ++st) { P0 = __builtin_amdgcn_mfma_f32_32x32x16_bf16(ka_[st], qf[st], P0, 0, 0, 0); P1 = __builtin_amdgcn_mfma_f32_32x32x16_bf16(kb_[st], qf[st], P1, 0, 0, 0); } } while (0)
#define ATT_ROWMAX(MX, P0, P1) do { float a_ = max2f(P0[0], P1[0]), b_ = max2f(P0[1], P1[1]), c_ = max2f(P0[2], P1[2]), d_ = max2f(P0[3], P1[3]); \
        _Pragma("unroll") for (int r = 4; r < 16; r += 4) { a_ = max2f(a_, max2f(P0[r], P1[r])); b_ = max2f(b_, max2f(P0[r + 1], P1[r + 1])); c_ = max2f(c_, max2f(P0[r + 2], P1[r + 2])); d_ = max2f(d_, max2f(P0[r + 3], P1[r + 3])); } \
        MX = max2f(max2f(a_, b_), max2f(c_, d_)); { auto rr_ = __builtin_amdgcn_permlane32_swap(__float_as_uint(MX), __float_as_uint(MX), false, false); MX = max2f(__uint_as_float(rr_[0]), __uint_as_float(rr_[1])); } } while (0)
    f32x16 pA0, pA1, pB0, pB1;
    constexpr bool fixed_ref = FIXED;
    if constexpr (FIXED) {
#pragma unroll
        for (int r = 0; r < 16; ++r) negm[r] = -sbound;
    }
    ATT_QK(pA0, pA1, 0);
    if constexpr (!FIXED) { float mx; ATT_ROWMAX(mx, pA0, pA1); mref = mx;
#pragma unroll
      for (int r = 0; r < 16; ++r) { pA0[r] -= mx; pA1[r] -= mx; negm[r] = -mref; } }
#define ATT_STEP(P0, P1, N0, N1, t) do { \
        const int cur_ = ((t) % 3) * ABUF, nx1_ = (((t) + 1) % 3) * ABUF, nx2_ = (((t) + 2) % 3) * ABUF; \
        const bool more1_ = (t) + 1 < SEQ / 64, more2_ = (t) + 2 < SEQ / 64; \
        if (more2_) ATT_STORE(nx2_); \
        if ((t) + 3 < SEQ / 64) ATT_LOAD((t) + 3); \
        float mx_; ATT_ROWMAX(mx_, P0, P1); \
        if (__any(mx_ > ATT_THR)) { const float dl_ = fmaxf(mx_, 0.f); mref += dl_; const float al_ = __builtin_amdgcn_exp2f(-dl_); lsum *= al_; \
            _Pragma("unroll") for (int r = 0; r < 16; ++r) { P0[r] -= dl_; P1[r] -= dl_; o0[r] *= al_; o1[r] *= al_; negm[r] = -mref; } } \
        if (more1_) ATT_QK(N0, N1, nx1_); \
        float ls_ = 0.f; \
        _Pragma("unroll") for (int r = 0; r < 16; ++r) { P0[r] = __builtin_amdgcn_exp2f(P0[r]); P1[r] = __builtin_amdgcn_exp2f(P1[r]); ls_ += P0[r] + P1[r]; } \
        lsum += ls_; \
        bf16x8 pb_[2][2]; \
        _Pragma("unroll") for (int s2 = 0; s2 < 2; ++s2) { u32x4 w0_, w1_; \
            w0_.x = cvtpk_s(P0[8 * s2 + 0], P0[8 * s2 + 1]); w0_.y = cvtpk_s(P0[8 * s2 + 2], P0[8 * s2 + 3]); w0_.z = cvtpk_s(P0[8 * s2 + 4], P0[8 * s2 + 5]); w0_.w = cvtpk_s(P0[8 * s2 + 6], P0[8 * s2 + 7]); \
            w1_.x = cvtpk_s(P1[8 * s2 + 0], P1[8 * s2 + 1]); w1_.y = cvtpk_s(P1[8 * s2 + 2], P1[8 * s2 + 3]); w1_.z = cvtpk_s(P1[8 * s2 + 4], P1[8 * s2 + 5]); w1_.w = cvtpk_s(P1[8 * s2 + 6], P1[8 * s2 + 7]); \
            pb_[0][s2] = __builtin_bit_cast(bf16x8, w0_); pb_[1][s2] = __builtin_bit_cast(bf16x8, w1_); } \
        bf16x8 va_[4], vb_[4]; \
        _Pragma("unroll") for (int i_ = 0; i_ < 4; ++i_) { va_[i_] = *(const LAS bf16x8*)(lds + cur_ + vro + i_ * 32); vb_[i_] = *(const LAS bf16x8*)(lds + cur_ + vro + 32 * AVP + i_ * 32); } \
        _Pragma("unroll") for (int i_ = 0; i_ < 4; ++i_) { \
            o0 = __builtin_amdgcn_mfma_f32_32x32x16_bf16(va_[i_], pb_[i_ >> 1][i_ & 1], o0, 0, 0, 0); o1 = __builtin_amdgcn_mfma_f32_32x32x16_bf16(vb_[i_], pb_[i_ >> 1][i_ & 1], o1, 0, 0, 0); } \
        __syncthreads(); } while (0)
    f32x16 lacc = {};
#if ATT_USE_SCHED
#define SGB(mask, n) __builtin_amdgcn_sched_group_barrier(mask, n, 0)
#define ATT_SCHED() do { SGB(0x100, 4); \
        _Pragma("unroll") for (int i_ = 0; i_ < 8; ++i_) { SGB(0x008, 1); SGB(0x100, 1); SGB(0x400, 4); } \
        _Pragma("unroll") for (int i_ = 0; i_ < 4; ++i_) { SGB(0x008, 1); SGB(0x100, 2); SGB(0x002, 6); } \
        _Pragma("unroll") for (int i_ = 0; i_ < 8; ++i_) { SGB(0x008, 1); SGB(0x002, 4); } } while (0)
#else
#define ATT_SCHED() do {} while (0)
#endif
#define ATT_STEP_FIXED(P0, P1, N0, N1, t) do { \
        const int cur_ = ((t) % 3) * ABUF, nx1_ = (((t) + 1) % 3) * ABUF, nx2_ = (((t) + 2) % 3) * ABUF; \
        const bool more1_ = (t) + 1 < SEQ / 64, more2_ = (t) + 2 < SEQ / 64; \
        if (more2_) ATT_STORE(nx2_); \
        if ((t) + 3 < SEQ / 64) ATT_LOAD((t) + 3); \
        if (more1_) ATT_QK(N0, N1, nx1_); \
        _Pragma("unroll") for (int r = 0; r < 16; ++r) { P0[r] = __builtin_amdgcn_exp2f(P0[r]); P1[r] = __builtin_amdgcn_exp2f(P1[r]); } \
        lacc = lacc + (P0 + P1); \
        bf16x8 pb_[2][2]; \
        _Pragma("unroll") for (int s2 = 0; s2 < 2; ++s2) { u32x4 w0_, w1_; \
            w0_.x = cvtpk_s(P0[8 * s2 + 0], P0[8 * s2 + 1]); w0_.y = cvtpk_s(P0[8 * s2 + 2], P0[8 * s2 + 3]); w0_.z = cvtpk_s(P0[8 * s2 + 4], P0[8 * s2 + 5]); w0_.w = cvtpk_s(P0[8 * s2 + 6], P0[8 * s2 + 7]); \
            w1_.x = cvtpk_s(P1[8 * s2 + 0], P1[8 * s2 + 1]); w1_.y = cvtpk_s(P1[8 * s2 + 2], P1[8 * s2 + 3]); w1_.z = cvtpk_s(P1[8 * s2 + 4], P1[8 * s2 + 5]); w1_.w = cvtpk_s(P1[8 * s2 + 6], P1[8 * s2 + 7]); \
            pb_[0][s2] = __builtin_bit_cast(bf16x8, w0_); pb_[1][s2] = __builtin_bit_cast(bf16x8, w1_); } \
        bf16x8 va_[4], vb_[4]; \
        _Pragma("unroll") for (int i_ = 0; i_ < 4; ++i_) { va_[i_] = *(const LAS bf16x8*)(lds + cur_ + vro + i_ * 32); vb_[i_] = *(const LAS bf16x8*)(lds + cur_ + vro + 32 * AVP + i_ * 32); } \
        _Pragma("unroll") for (int i_ = 0; i_ < 4; ++i_) { \
            o0 = __builtin_amdgcn_mfma_f32_32x32x16_bf16(va_[i_], pb_[i_ >> 1][i_ & 1], o0, 0, 0, 0); o1 = __builtin_amdgcn_mfma_f32_32x32x16_bf16(vb_[i_], pb_[i_ >> 1][i_ & 1], o1, 0, 0, 0); } \
        ATT_SCHED(); \
        __syncthreads(); } while (0)
    if constexpr (FIXED) { for (int kt = 0; kt < SEQ / 64; kt += 2) { ATT_STEP_FIXED(pA0, pA1, pB0, pB1, kt); ATT_STEP_FIXED(pB0, pB1, pA0, pA1, kt + 1); }
#pragma unroll
        for (int r = 0; r < 16; ++r) lsum += lacc[r]; }
    else { for (int kt = 0; kt < SEQ / 64; kt += 2) { ATT_STEP(pA0, pA1, pB0, pB1, kt); ATT_STEP(pB0, pB1, pA0, pA1, kt + 1); } }
#undef ATT_STEP_FIXED
#undef ATT_STEP
#undef ATT_ROWMAX
#undef ATT_QK
#undef ATT_LOAD
#undef ATT_STORE
    lsum += __shfl_xor(lsum, 32);
    const float inv = 1.f / lsum;
    bf16* orow = O + (tok0 + r32) * 512 + h * 64 + 4 * hi;
#pragma unroll
    for (int g4 = 0; g4 < 4; ++g4) {
        u32x2 w; w.x = pk2(o0[4 * g4] * inv, o0[4 * g4 + 1] * inv); w.y = pk2(o0[4 * g4 + 2] * inv, o0[4 * g4 + 3] * inv); *(u32x2*)(orow + 8 * g4) = w;
        w.x = pk2(o1[4 * g4] * inv, o1[4 * g4 + 1] * inv); w.y = pk2(o1[4 * g4 + 2] * inv, o1[4 * g4 + 3] * inv); *(u32x2*)(orow + 32 + 8 * g4) = w;
    }
}

#ifndef EN_P0
#define EN_P0 1
#endif
#ifndef EN_P1
#define EN_P1 1
#endif
#ifndef EN_P2
#define EN_P2 1
#endif
#ifndef EN_P3
#define EN_P3 1
#endif
#ifndef EN_P4
#define EN_P4 1
#endif
#ifndef EN_P5
#define EN_P5 1
#endif
#ifndef EN_P6
#define EN_P6 1
#endif
#ifndef EN_P7
#define EN_P7 1
#endif
#ifndef EN_P8
#define EN_P8 1
#endif
#ifndef EN_P9
#define EN_P9 1
#endif
#ifndef PROBE_ATTN_REPS
#define PROBE_ATTN_REPS 1
#endif
#ifndef PROBE_NULL_GEMM
#define PROBE_NULL_GEMM 0
#endif
#ifndef PROBE_G1_REPS
#define PROBE_G1_REPS 1
#endif
#ifndef PROBE_G2_REPS
#define PROBE_G2_REPS 1
#endif
#ifndef PROBE_G5_REPS
#define PROBE_G5_REPS 1
#endif
#ifndef PROBE_G6_REPS
#define PROBE_G6_REPS 1
#endif
#ifndef PROBE_PRO_REPS
#define PROBE_PRO_REPS 1
#endif
#ifndef PROBE_SYNC_REPS
#define PROBE_SYNC_REPS 1
#endif
#ifndef PROBE_MISC_REPS
#define PROBE_MISC_REPS 1
#endif
#ifndef PROBE_FF1_REPS
#define PROBE_FF1_REPS 1
#endif
#ifndef PROBE_SSMC_REPS
#define PROBE_SSMC_REPS 1
#endif
constexpr int LDS_BYTES = 131072 + 64 + 4096;
constexpr int PH_PER_LAYER = 9, N_PHASES = 1 + DEPTH * PH_PER_LAYER;
#define XB_TMO      128
#define XB_XCNT(j)  (256  + 64 * (j))
#define XB_XSUB(j)  (1280 + 64 * (j))
#define XB_XGEN(j)  (2304 + 64 * (j))
#define XB_TOP      3328
#define XB_TOPGEN   3392
#define XCD_BAR_WORDS 3456
#define XB_SPIN_CAP (1u << 18)

__device__ __forceinline__ unsigned xb_ld(unsigned* p)              { return __hip_atomic_load(p, __ATOMIC_RELAXED, __HIP_MEMORY_SCOPE_AGENT); }
__device__ __forceinline__ unsigned xb_add(unsigned* p, unsigned v) { return __hip_atomic_fetch_add(p, v, __ATOMIC_RELAXED, __HIP_MEMORY_SCOPE_AGENT); }
__device__ __forceinline__ unsigned xb_xcc_id() { return (unsigned)__builtin_amdgcn_s_getreg((3 << 11) | 20) & 0xFu; }
#define XB_SPIN(cond, bar) do { unsigned _sp = 0; while (cond) { __builtin_amdgcn_s_sleep(1); \
    if ((++_sp & 255u) == 0u) { if (xb_ld(&(bar)[XB_TMO])) break; if (_sp > XB_SPIN_CAP) { atomicAdd(&(bar)[XB_TMO], 1u); break; } } } } while (0)

struct XcdBarrier {
    unsigned* bar; unsigned x;
    volatile LAS unsigned* st;
};

__device__ __forceinline__ XcdBarrier xcd_barrier_post(unsigned* bar, volatile LAS unsigned* st, bool t0) {
    XcdBarrier b; b.bar = bar; b.x = xb_xcc_id(); b.st = st;
    if (t0) (void)xb_add(&bar[XB_XCNT(b.x)], 1u);
    return b;
}
__device__ __forceinline__ void xcd_barrier_complete(unsigned* bar, unsigned x, unsigned& nloc, unsigned& nx) {
    const unsigned G = gridDim.x * gridDim.y * gridDim.z;
    unsigned sum, cnt, mine, sp = 0u;
    for (;;) {
        sum = 0u; cnt = 0u; mine = 0u;
#pragma unroll
        for (unsigned j = 0; j < 16; ++j) { const unsigned c = xb_ld(&bar[XB_XCNT(j)]); sum += c; cnt += (c > 0u) ? 1u : 0u; mine = (j == x) ? c : mine; }
        if (sum == G) break;
        __builtin_amdgcn_s_sleep(1);
        if ((++sp & 255u) == 0u) { if (xb_ld(&bar[XB_TMO])) break; if (sp > XB_SPIN_CAP) { atomicAdd(&bar[XB_TMO], 1u); break; } }
    }
    nloc = mine > 0u ? mine : 1u; nx = cnt > 0u ? cnt : 1u;
}

__device__ __forceinline__ void xcd_barrier(const XcdBarrier& b, bool t0) {
    asm volatile("s_waitcnt vmcnt(0)" ::: "memory");
    __syncthreads();
    if (t0) {
        unsigned* bar = b.bar;
        __builtin_amdgcn_s_waitcnt(0);
        unsigned nloc = b.st[0], nx = b.st[1];
        if (nloc == 0u) { xcd_barrier_complete(bar, b.x, nloc, nx); b.st[0] = nloc; b.st[1] = nx; }
        const unsigned old = xb_add(&bar[XB_XSUB(b.x)], 1u);
        const unsigned gen = old / nloc;
        if (old + 1u == (gen + 1u) * nloc) {
            __builtin_amdgcn_fence(__ATOMIC_RELEASE, "agent");
            asm volatile("s_waitcnt vmcnt(0)" ::: "memory");
            const unsigned og = xb_add(&bar[XB_TOP], 1u);
            const unsigned tg = og / nx;
            if (og + 1u == (tg + 1u) * nx) xb_add(&bar[XB_TOPGEN], 1u);
            else XB_SPIN(xb_ld(&bar[XB_TOPGEN]) == tg, bar);
            __builtin_amdgcn_fence(__ATOMIC_ACQUIRE, "agent");
            xb_add(&bar[XB_XGEN(b.x)], 1u);
            asm volatile("s_waitcnt vmcnt(0)" ::: "memory");
        } else {
            XB_SPIN(xb_ld(&bar[XB_XGEN(b.x)]) == gen, bar);
            __builtin_amdgcn_fence(__ATOMIC_ACQUIRE, "agent");
            asm volatile("s_waitcnt vmcnt(0)" ::: "memory");
        }
    }
    __syncthreads();
}


__global__ void __launch_bounds__(NTHREADS) mega_fwd(Params P) {
    extern __shared__ __attribute__((aligned(16))) unsigned char lds_raw[];
    LAS unsigned char* lds = (LAS unsigned char*)lds_raw;
    cg::grid_group grid = cg::this_grid();
    unsigned char* ws = P.ws; float* out = P.out;
    const float* sm = (const float*)(ws + WS_SMALL);
    const int G = gridDim.x, NGW = G * NWAVES;
    const int wv = __builtin_amdgcn_readfirstlane((int)threadIdx.x >> 6);
    const int vcu0 = (G % 8 == 0) ? ((int)blockIdx.x % 8) * (G / 8) + (int)blockIdx.x / 8 : (int)blockIdx.x;
    int ph = 0;
#define PHASE_BEGIN if (ph >= P.ph_lo && ph < P.ph_hi) { const int tid = opaque_tid(wv); int bx = blockIdx.x; asm volatile("" : "+s"(bx)); const int wave = tid >> 6, gw = bx * NWAVES + wave; \
        int vcu = vcu0; asm volatile("" : "+s"(vcu)); (void)gw; (void)vcu; (void)wave;
#define PHASE_END   if (ph + 1 < P.ph_hi) { for (int rs_ = 0; rs_ < PROBE_SYNC_REPS; ++rs_) xcd_barrier(bar, opaque_tid(wv) == 0); } } ++ph;

    {
        const int tid = opaque_tid(wv);
        if (tid < 2) ((volatile LAS unsigned*)(lds + 131072))[tid] = 0u;
        if (blockIdx.x == 0) for (int i = tid; i < XCD_BAR_WORDS; i += NTHREADS) ((unsigned*)(ws + WS_BAR))[i] = 0u;
        for (int rep_ = 0; rep_ < PROBE_PRO_REPS; ++rep_) prologue(P, lds, tid);
        grid.sync();
    }
    XcdBarrier bar = xcd_barrier_post((unsigned*)(ws + WS_BAR), (volatile LAS unsigned*)(lds + 131072), opaque_tid(wv) == 0);
    ++ph;

    for (int l = 0; l < DEPTH; ++l) {
        unsigned char* wl = ws + WS_W + (size_t)l * W_STRIDE;
        float* pxm = (float*)(ws + WS_PXM); float* pxf = (float*)(ws + WS_PXF); float* pcq = (float*)(ws + WS_PCQ); float* pckv = (float*)(ws + WS_PCKV);
        bf16* xb = (bf16*)(ws + WS_XB);
        PHASE_BEGIN
#if EN_P1
            for (int rep_ = 0; rep_ < PROBE_MISC_REPS; ++rep_) { ssm_tables(ws, l, tid); for (int t = vcu; t < NG * 8; t += G) ssm_kt_task(ws, lds, l, t, tid); __syncthreads(); }
            for (int rg_ = 0; rg_ < PROBE_G1_REPS; ++rg_) run_gemm(lds, wv, xb, (const bf16*)(wl + WO_INS), NTOK, 1280, 1024, FInSmall{pxm, pcq, pckv, (bf16*)(ws + AR_U), (bf16*)(ws + AR_CKV), (bf16*)(ws + AR_CQ), (bf16*)(ws + AR_KR)});
#endif
        PHASE_END
        PHASE_BEGIN
#if EN_P2
#if PROBE_NULL_GEMM == 4
            run_gemm(lds, wv, (const bf16*)(ws + AR_CQ), (const bf16*)(wl + WO_Q), NTOK, 768, 384, FNull{});
            run_gemm(lds, wv, (const bf16*)(ws + AR_CKV), (const bf16*)(wl + WO_KN), NTOK, 512, 256, FNull{});
            run_gemm(lds, wv, (const bf16*)(wl + WO_V), (const bf16*)(ws + AR_CKV), 512, NTOK, 256, FNull{});
#endif
            for (int rg_ = 0; rg_ < PROBE_G2_REPS; ++rg_) {
            run_gemm(lds, wv, (const bf16*)(ws + AR_CQ), (const bf16*)(wl + WO_Q), NTOK, 768, 384, FScaled<8>{(bf16*)(ws + AR_Q), 768, pcq, 1.f / 384.f});
            run_gemm(lds, wv, (const bf16*)(ws + AR_CKV), (const bf16*)(wl + WO_KN), NTOK, 512, 256, FScaled<4>{(bf16*)(ws + AR_KN), 512, pckv, 1.f / 256.f});
            run_gemm(lds, wv, (const bf16*)(wl + WO_V), (const bf16*)(ws + AR_CKV), 512, NTOK, 256, FVt{(bf16*)(ws + AR_VT), pckv}); }
            { const int tid2 = opaque_tid(wv); for (int rep_ = 0; rep_ < PROBE_MISC_REPS; ++rep_) for (int t = vcu; t < NG * 8; t += G) ssm_a_task(ws, lds, t, tid2); }
#endif
        PHASE_END
        PHASE_BEGIN
#if EN_P3
            constexpr int SCAN_WG = NBATCH * NG * 2 * NS / NTHREADS;
            if (bx < SCAN_WG) { const int nsw = G < SCAN_WG ? G : SCAN_WG; for (int rep_ = 0; rep_ < PROBE_MISC_REPS; ++rep_) for (int t = bx * NTHREADS + tid; t < SCAN_WG * NTHREADS; t += nsw * NTHREADS) ssm_scan(ws, l, t); }
            else if (G > SCAN_WG) { for (int it = (bx - SCAN_WG) * NWAVES + wave; it < NTOK / 2; it += (G - SCAN_WG) * NWAVES) prep_item(ws, l, it, tid); }
            if (G <= SCAN_WG) { for (int it = gw; it < NTOK / 2; it += NGW) prep_item(ws, l, it, tid); }
#endif
        PHASE_END
        PHASE_BEGIN
#if EN_P4
            float sbound;
            { const float* qg = sm + SM_QG + l * QKD; const float* kg = sm + SM_KG + l * QKD; float gq = 0.f, gk = 0.f;
              for (int i = 0; i < QKD; ++i) { gq = fmaxf(gq, fabsf(qg[i])); gk = fmaxf(gk, fabsf(kg[i])); }
              sbound = 14.1352f * gq * gk * 1.01f + 0.25f; }
            for (int rep_ = 0; rep_ < PROBE_ATTN_REPS; ++rep_)
            for (int i = 0; i * G + vcu < NBATCH * NH * 32; ++i) { const int unit = i * G + vcu; const int bh = unit >> 5, qb = unit & 31; if (sbound <= 60.f) attn_unit<true>(ws, lds, bh >> 3, bh & 7, qb, tid, sbound); else attn_unit<false>(ws, lds, bh >> 3, bh & 7, qb, tid, sbound); }
            for (int rep_ = 0; rep_ < PROBE_SSMC_REPS; ++rep_)
            { const int tid3 = opaque_tid(wv);
#if PROBE_SC_MODE
              for (int t = vcu; t < NG * 8; t += G) ssm_c_task<PROBE_SC_MODE>(ws, lds, l, t, tid3);
#endif
              for (int rep_ = 0; rep_ < PROBE_SSMC_REPS; ++rep_) for (int t = vcu; t < NG * 8; t += G) ssm_c_task<0>(ws, lds, l, t, tid3); }
#endif
        PHASE_END
        PHASE_BEGIN
#if EN_P5
#if PROBE_NULL_GEMM == 3
            run_gemm(lds, wv, xb, (const bf16*)(wl + WO_G), NTOK, 2048, 1024, FNull{});
            run_gemm(lds, wv, (const bf16*)(ws + AR_YG), (const bf16*)(wl + WO_GLU), NTOK, 512, 512, FNull{}, NTOK);
#endif
            for (int rg_ = 0; rg_ < PROBE_G5_REPS; ++rg_) {
            run_gemm(lds, wv, xb, (const bf16*)(wl + WO_G), NTOK, 2048, 1024, FGates{(bf16*)(ws + AR_GATES), pxm, sm + SM_BG + (size_t)l * 2048});
            run_gemm(lds, wv, (const bf16*)(ws + AR_YG), (const bf16*)(wl + WO_GLU), NTOK, 512, 512, FGlu{(bf16*)(ws + AR_YSSM), (const bf16*)(ws + AR_YG), sm + SM_BGLU + (size_t)l * 512}, NTOK); }
#endif
        PHASE_END
        PHASE_BEGIN
#if EN_P6
#if PROBE_NULL_GEMM == 2
            run_gemm(lds, wv, (const bf16*)(ws + AR_YSSM), (const bf16*)(wl + WO_OS), NTOK, 1024, 512, FNull{});
            run_gemm(lds, wv, (const bf16*)(ws + AR_O), (const bf16*)(wl + WO_OM), NTOK, 1024, 512, FNull{});
#endif
            run_gemm_chain(lds, wv, (const bf16*)(ws + AR_YSSM), (const bf16*)(wl + WO_OS), (const bf16*)(ws + AR_O), (const bf16*)(wl + WO_OM), NTOK, 1024, 512, FOutChain{(bf16*)(ws + AR_MRG), (const bf16*)(ws + AR_GATES)});
#endif
        PHASE_END
        PHASE_BEGIN
#if EN_P7
#if PROBE_NULL_GEMM == 5
            run_gemm(lds, wv, (const bf16*)(ws + AR_MRG), (const bf16*)(wl + WO_O), NTOK, 1024, 1024, FNull{});
#endif
            if (l == 0) run_gemm(lds, wv, (const bf16*)(ws + AR_MRG), (const bf16*)(wl + WO_O), NTOK, 1024, 1024, FResid{P.in[0], out, xb, pxf});
            else run_gemm(lds, wv, (const bf16*)(ws + AR_MRG), (const bf16*)(wl + WO_O), NTOK, 1024, 1024, FResid{out, out, xb, pxf});
#endif
        PHASE_END
        PHASE_BEGIN
#if EN_P8
#if PROBE_NULL_GEMM == 6
            run_gemm(lds, wv, xb, (const bf16*)(wl + WO_1), NTOK, 4096, 1024, FNull{});
#endif
            for (int rep_ = 0; rep_ < PROBE_FF1_REPS; ++rep_) run_gemm(lds, wv, xb, (const bf16*)(wl + WO_1), NTOK, 4096, 1024, FFf1{(bf16*)(ws + AR_HID), pxf});
#endif
        PHASE_END
        PHASE_BEGIN
#if EN_P9
#if PROBE_NULL_GEMM == 1
            run_gemm(lds, wv, (const bf16*)(ws + AR_HID), (const bf16*)(wl + WO_2), NTOK, 1024, 4096, FNull{});
#endif
            run_gemm(lds, wv, (const bf16*)(ws + AR_HID), (const bf16*)(wl + WO_2), NTOK, 1024, 4096, FResid{out, out, xb, l + 1 < DEPTH ? pxm : nullptr});
#endif
        PHASE_END
    }
}

extern "C" void kernel_launch(void* const* d_in, const int* in_sizes, int n_in, void* d_out, int out_size, void* d_ws, size_t ws_size, hipStream_t stream) {
    static int grid = 0;
    if (grid == 0) {
        if (n_in != 26 || ws_size < WS_END) { fprintf(stderr, "kernel_launch: unexpected n_in %d / ws_size %zu (need %zu)\n", n_in, ws_size, (size_t)WS_END); grid = -1; return; }
        int dev = 0, cus = 0, per_cu = 0;
        hipGetDevice(&dev); hipDeviceGetAttribute(&cus, hipDeviceAttributeMultiprocessorCount, dev);
        if (hipFuncSetAttribute((const void*)mega_fwd, hipFuncAttributeMaxDynamicSharedMemorySize, LDS_BYTES) != hipSuccess) { fprintf(stderr, "kernel_launch: hipFuncSetAttribute failed\n"); }
        hipOccupancyMaxActiveBlocksPerMultiprocessor(&per_cu, (const void*)mega_fwd, NTHREADS, LDS_BYTES);
        (void)hipGetLastError();
        if (per_cu < 1) per_cu = 1;
        grid = cus * 1;
        fprintf(stderr, "kernel_launch: cus %d per_cu %d grid %d\n", cus, per_cu, grid);
    }
    if (grid < 0) return;
    Params p{};
    for (int i = 0; i < 26; ++i) p.in[i] = (const float*)d_in[i];
    p.out = (float*)d_out; p.ws = (unsigned char*)d_ws; p.ph_lo = 0; p.ph_hi = N_PHASES;
    void* args[] = {&p};
    hipError_t e = hipLaunchCooperativeKernel((const void*)mega_fwd, dim3(grid), dim3(NTHREADS), args, LDS_BYTES, stream);
    if (e != hipSuccess) fprintf(stderr, "cooperative launch failed: %s (grid %d)\n", hipGetErrorString(e), grid);
}
```
